# Optimizing an MI355X kernel written in HIP

```python
import math
import jax, jax.numpy as jnp
from jax import lax
import numpy as np

D_MODEL = 2048
BATCH = 8
SEQ = 2048
DEPTH = 2

GRID_W = 64
CTX_LEN = 256
HY_W = D_MODEL // 4
ML_W = 3 * D_MODEL // 8
RT_W = 3 * D_MODEL // 8
HY_EMB = 33
HY_BANDS = (HY_EMB - 1) // 2
HY_FF = 64
HY_DECAY_TARGET = 1e-2
HY_SHORT_PCT = 0.3
HY_LONG_PCT = 1.5
ML_HEADS = 4
ML_DH = ML_W // ML_HEADS
ML_CHUNK = 128
RT_HEADS = 4
RT_DV = RT_W // RT_HEADS
RT_DK = RT_DV // 2
RT_CHUNK = 128
ROPE_BASE = 10000.0
D_FF = 4 * D_MODEL
N_MOD = 6
EPS = 1e-6
HY_COLS = 3 * HY_W
ML_COLS = 4 * ML_W
MLG_COLS = 4 * ML_HEADS
RT_COLS = 2 * RT_HEADS * RT_DK + 2 * RT_W
N_IN = HY_COLS + ML_COLS + MLG_COLS + RT_COLS
SPLITS = [HY_COLS, HY_COLS + ML_COLS, HY_COLS + ML_COLS + MLG_COLS]

kernel_name = "hybrid_hyena_mlstm_retention_dit_prefix"


def rms_norm(x, g):
    xf = x.astype(jnp.float32)
    y = xf * lax.rsqrt(jnp.mean(xf * xf, axis=-1, keepdims=True) + EPS)
    return (y * g.astype(jnp.float32)).astype(x.dtype)


def _head_rms(h):
    return h * lax.rsqrt(jnp.mean(h * h, axis=-1, keepdims=True) + EPS)


def modulate(h, shift, scale):
    return h * (1.0 + scale) + shift


def short_conv3(u, w):
    up = jnp.pad(u, ((0, 0), (1, 1), (0, 0)))
    return up[:, :-2] * w[0] + up[:, 1:-1] * w[1] + up[:, 2:] * w[2]


def _heads(a, n_heads, dh):
    B, L, _ = a.shape
    return a.reshape(B, L, n_heads, dh).transpose(0, 2, 1, 3).astype(jnp.float32)


def _chunks(a, T):
    B, H, L = a.shape[:3]
    return jnp.moveaxis(a.reshape(B, H, L // T, T, *a.shape[3:]), 2, 0)


def _unchunk(a):
    nc, B, H, T = a.shape[:4]
    return jnp.moveaxis(a, 0, 2).reshape(B, H, nc * T, *a.shape[4:])


def hyena_filter(L, w1, b1, w2, b2, w3, freq):
    f32 = jnp.float32
    t = jnp.linspace(0.0, 1.0, L, dtype=f32)[:, None]
    w = (2.0 * math.pi / L) * jnp.arange(L, dtype=f32)[:, None]
    bands = jnp.linspace(1e-4, HY_BANDS - 1, HY_BANDS, dtype=f32)[None, :]
    z = jnp.concatenate([t, jnp.cos(bands * w), -jnp.sin(bands * w)], axis=-1)
    fr = freq.astype(f32)
    hdn = jnp.sin(fr * (z @ w1.astype(f32) + b1.astype(f32)))
    hdn = jnp.sin(fr * (hdn @ w2.astype(f32) + b2.astype(f32)))
    h = (hdn @ w3.astype(f32)).reshape(L, 2, HY_W)
    deltas = jnp.abs(jnp.linspace(math.log(HY_DECAY_TARGET) / HY_LONG_PCT,
                                  math.log(HY_DECAY_TARGET) / HY_SHORT_PCT, HY_W, dtype=f32))
    h = h * jnp.exp(-t * deltas)[:, None, :]
    hf, hb = h[:, 0], h[:, 1]
    filt = jnp.concatenate([hf, jnp.zeros((1, HY_W), f32), hb[:0:-1]], axis=0)
    return filt / jnp.sum(jnp.abs(filt), axis=0, keepdims=True)


def fft_long_conv(u, filt, bias):
    L = u.shape[1]
    uf = jnp.fft.rfft(u.astype(jnp.float32), n=2 * L, axis=1)
    ff = jnp.fft.rfft(filt, n=2 * L, axis=0)
    y = jnp.fft.irfft(uf * ff[None], n=2 * L, axis=1)[:, :L]
    return (y + u.astype(jnp.float32) * bias.astype(jnp.float32)).astype(u.dtype)


def hyena_mixer(p, conv_w, filt, bias):
    u = short_conv3(p, conv_w)
    x0, x1, v = jnp.split(u, 3, axis=-1)
    return fft_long_conv(v * x1, filt, bias) * x0


def mlstm_scan(q, k, v, log_i, log_f, state):
    T = ML_CHUNK
    causal = jnp.tril(jnp.ones((T, T), dtype=bool))

    def step(carry, xs):
        C, n, m = carry
        qc, kc, vc, ic, fc = xs
        b = jnp.cumsum(fc, axis=-1)
        dmat = jnp.where(causal, b[..., :, None] - b[..., None, :] + ic[..., None, :], -jnp.inf)
        m_inter = b + m[..., None]
        m_t = jnp.maximum(m_inter, jnp.max(dmat, axis=-1))
        s = jnp.einsum("bhtd,bhsd->bhts", qc, kc) * jnp.exp(dmat - m_t[..., None])
        w_inter = jnp.exp(m_inter - m_t)
        num = jnp.einsum("bhts,bhse->bhte", s, vc) + w_inter[..., None] * jnp.einsum("bhtd,bhde->bhte", qc, C)
        den = jnp.sum(s, axis=-1) + w_inter * jnp.einsum("bhtd,bhd->bht", qc, n)
        h = num / jnp.maximum(jnp.abs(den), jnp.exp(-m_t))[..., None]
        b_end = b[..., -1]
        g = b_end[..., None] - b + ic
        m_new = jnp.maximum(b_end + m, jnp.max(g, axis=-1))
        wk = jnp.exp(g - m_new[..., None])
        carry_decay = jnp.exp(b_end + m - m_new)
        C_new = carry_decay[..., None, None] * C + jnp.einsum("bhsd,bhse->bhde", kc * wk[..., None], vc)
        n_new = carry_decay[..., None] * n + jnp.einsum("bhsd,bhs->bhd", kc, wk)
        return (C_new, n_new, m_new), h

    xs = (_chunks(q, T), _chunks(k, T), _chunks(v, T), _chunks(log_i, T), _chunks(log_f, T))
    state, hs = lax.scan(step, state, xs)
    return _unchunk(hs), state


def _mlstm_prep(p, graw, conv_w, gate_b):
    qk, v, o = jnp.split(p, [2 * ML_W, 3 * ML_W], axis=-1)
    qk = jax.nn.silu(short_conv3(qk, conv_w))
    q, k = jnp.split(qk, 2, axis=-1)
    q = _heads(q, ML_HEADS, ML_DH)
    k = _heads(k, ML_HEADS, ML_DH) * (ML_DH ** -0.5)
    v = _heads(v, ML_HEADS, ML_DH)
    B, L, _ = p.shape
    gates = (graw + gate_b).astype(jnp.float32).reshape(B, L, 4, ML_HEADS).transpose(2, 0, 3, 1)
    g_fwd = (gates[0], jax.nn.log_sigmoid(gates[1]))
    g_bwd = (gates[2], jax.nn.log_sigmoid(gates[3]))
    return q, k, v, o, g_fwd, g_bwd


def _mlstm_bidir(q, k, v, g_fwd, g_bwd, init_f, init_b):
    h_f, st_f = mlstm_scan(q, k, v, g_fwd[0], g_fwd[1], init_f)
    fl = lambda a: jnp.flip(a, axis=2)
    h_b, st_b = mlstm_scan(fl(q), fl(k), fl(v), fl(g_bwd[0]), fl(g_bwd[1]), init_b)
    return h_f + fl(h_b), st_f, st_b


def _mlstm_out(h, o, g):
    B, H, L, dh = h.shape
    hn = _head_rms(h) * g.astype(jnp.float32).reshape(H, 1, dh)
    return (hn.transpose(0, 2, 1, 3).reshape(B, L, H * dh) * jax.nn.sigmoid(o.astype(jnp.float32))).astype(o.dtype)


def mlstm_group(pc, gc, px, gx, conv_w, gate_b, norm_g):
    B = pc.shape[0]
    f32 = jnp.float32
    zero = (jnp.zeros((B, ML_HEADS, ML_DH, ML_DH), f32), jnp.zeros((B, ML_HEADS, ML_DH), f32),
            jnp.zeros((B, ML_HEADS), f32))
    qc, kc, vc, oc, gfc, gbc = _mlstm_prep(pc, gc, conv_w, gate_b)
    hc, st_f, st_b = _mlstm_bidir(qc, kc, vc, gfc, gbc, zero, zero)
    qx, kx, vx, ox, gfx, gbx = _mlstm_prep(px, gx, conv_w, gate_b)
    hx, _, _ = _mlstm_bidir(qx, kx, vx, gfx, gbx, st_f, st_b)
    return _mlstm_out(hc, oc, norm_g), _mlstm_out(hx, ox, norm_g)


def axial_rope(L):
    rows = L // GRID_W
    r = jnp.repeat(jnp.arange(rows, dtype=jnp.float32), GRID_W)
    col = jnp.tile(jnp.arange(GRID_W, dtype=jnp.float32), rows)
    nf = RT_DK // 4
    inv = ROPE_BASE ** (-jnp.arange(nf, dtype=jnp.float32) / nf)
    ang = jnp.concatenate([r[:, None] * inv, col[:, None] * inv], axis=-1)
    return jnp.cos(ang), jnp.sin(ang)


def apply_rope(a, cos, sin):
    a1, a2 = jnp.split(a, 2, axis=-1)
    return jnp.concatenate([a1 * cos - a2 * sin, a1 * sin + a2 * cos], axis=-1)


def retention_scan(q, k, v, log_g, S):
    T = RT_CHUNK
    idx = jnp.arange(T, dtype=jnp.float32)
    rel = idx[:, None] - idx[None, :]
    dmask = jnp.where(rel >= 0, jnp.exp(log_g[:, None, None] * jnp.maximum(rel, 0.0)), 0.0)
    q_decay = jnp.exp(log_g[:, None] * (idx + 1.0))[..., None]
    k_decay = jnp.exp(log_g[:, None] * (T - 1.0 - idx))[..., None]
    c_decay = jnp.exp(log_g * T)[:, None, None]

    def step(S, xs):
        qc, kc, vc = xs
        s = jnp.einsum("bhtd,bhsd->bhts", qc, kc) * dmask
        o = jnp.einsum("bhts,bhse->bhte", s, vc) + q_decay * jnp.einsum("bhtd,bhde->bhte", qc, S)
        S = c_decay * S + jnp.einsum("bhsd,bhse->bhde", kc * k_decay, vc)
        return S, o

    S, os_ = lax.scan(step, S, (_chunks(q, T), _chunks(k, T), _chunks(v, T)))
    return _unchunk(os_), S


def _ret_prep(p, rope):
    nqk = RT_HEADS * RT_DK
    q, k, v, g = jnp.split(p, [nqk, 2 * nqk, 2 * nqk + RT_W], axis=-1)
    q = _heads(q, RT_HEADS, RT_DK)
    k = _heads(k, RT_HEADS, RT_DK)
    v = _heads(v, RT_HEADS, RT_DV)
    if rope is not None:
        q = apply_rope(q, rope[0], rope[1])
        k = apply_rope(k, rope[0], rope[1])
    return q * (RT_DK ** -0.5), k, v, g


def _ret_bidir(q, k, v, lg_f, lg_b, init_f, init_b):
    o_f, S_f = retention_scan(q, k, v, lg_f, init_f)
    fl = lambda a: jnp.flip(a, axis=2)
    o_b, S_b = retention_scan(fl(q), fl(k), fl(v), lg_b, init_b)
    return o_f + fl(o_b), S_f, S_b


def _ret_out(o, g):
    B, H, L, dv = o.shape
    on = _head_rms(o).transpose(0, 2, 1, 3).reshape(B, L, H * dv)
    return (on * jax.nn.silu(g.astype(jnp.float32))).astype(g.dtype)


def retention_group(pc, px, log_decay, rope):
    lg_f = -jnp.exp(log_decay[0].astype(jnp.float32))
    lg_b = -jnp.exp(log_decay[1].astype(jnp.float32))
    B = pc.shape[0]
    zero = jnp.zeros((B, RT_HEADS, RT_DK, RT_DV), jnp.float32)
    qc, kc, vc, gc = _ret_prep(pc, None)
    oc, S_f, S_b = _ret_bidir(qc, kc, vc, lg_f, lg_b, zero, zero)
    qx, kx, vx, gx = _ret_prep(px, rope)
    ox, _, _ = _ret_bidir(qx, kx, vx, lg_f, lg_b, S_f, S_b)
    return _ret_out(oc, gc), _ret_out(ox, gx)


def sq_relu_mlp(h, w1, w2):
    return jnp.square(jax.nn.relu(h @ w1)) @ w2


def setup_inputs(seed: int = 0) -> dict:
    key = jax.random.key(seed)
    ks = jax.random.split(key, 32)
    f32 = jnp.float32
    nrm = lambda k, shape, s: jax.random.normal(k, shape, f32) * s
    D = D_MODEL
    i_b = nrm(ks[17], (DEPTH, 2, ML_HEADS), 0.1)
    f_b = jnp.linspace(3.0, 6.0, ML_HEADS, dtype=f32) + nrm(ks[18], (DEPTH, 2, ML_HEADS), 0.1)
    ml_gate_b = jnp.stack([i_b[:, 0], f_b[:, 0], i_b[:, 1], f_b[:, 1]], axis=1).reshape(DEPTH, MLG_COLS)
    base = jnp.log(-jnp.log(1.0 - 2.0 ** (-5.0 - jnp.arange(RT_HEADS, dtype=f32))))
    return {
        "x": nrm(ks[0], (BATCH, SEQ, D), 1.0),
        "c": nrm(ks[1], (BATCH, D), 1.0),
        "ctx": nrm(ks[2], (BATCH, CTX_LEN, D), 1.0),
        "c_ctx": nrm(ks[3], (D,), 1.0),
        "norm1_g": 1.0 + nrm(ks[4], (DEPTH, D), 0.02),
        "norm2_g": 1.0 + nrm(ks[5], (DEPTH, D), 0.02),
        "w_mod": nrm(ks[6], (DEPTH, D, N_MOD * D), D ** -0.5),
        "b_mod": nrm(ks[7], (DEPTH, N_MOD * D), 0.02),
        "w_in": nrm(ks[8], (DEPTH, D, N_IN), D ** -0.5),
        "hy_conv_w": nrm(ks[9], (DEPTH, 3, HY_COLS), 3 ** -0.5),
        "hy_f_w1": nrm(ks[10], (DEPTH, HY_EMB, HY_FF), HY_EMB ** -0.5),
        "hy_f_b1": nrm(ks[11], (DEPTH, HY_FF), 0.02),
        "hy_f_w2": nrm(ks[12], (DEPTH, HY_FF, HY_FF), HY_FF ** -0.5),
        "hy_f_b2": nrm(ks[13], (DEPTH, HY_FF), 0.02),
        "hy_f_w3": nrm(ks[14], (DEPTH, HY_FF, 2 * HY_W), HY_FF ** -0.5),
        "hy_f_freq": 1.0 + nrm(ks[15], (DEPTH, HY_FF), 0.02),
        "hy_bias": nrm(ks[16], (DEPTH, HY_W), 0.5),
        "ml_conv_w": nrm(ks[19], (DEPTH, 3, 2 * ML_W), 3 ** -0.5),
        "ml_gate_b": ml_gate_b,
        "ml_norm_g": 1.0 + nrm(ks[20], (DEPTH, ML_W), 0.02),
        "rt_log_decay": base + nrm(ks[21], (DEPTH, 2, RT_HEADS), 0.05),
        "w_out": nrm(ks[22], (DEPTH, D, D), D ** -0.5),
        "w_ff1": nrm(ks[23], (DEPTH, D, D_FF), D ** -0.5),
        "w_ff2": nrm(ks[24], (DEPTH, D_FF, D), D_FF ** -0.5),
        "final_g": 1.0 + nrm(ks[25], (D,), 0.02),
    }


def reference(x, c, ctx, c_ctx, norm1_g, norm2_g, w_mod, b_mod, w_in, hy_conv_w, hy_f_w1, hy_f_b1,
              hy_f_w2, hy_f_b2, hy_f_w3, hy_f_freq, hy_bias, ml_conv_w, ml_gate_b, ml_norm_g,
              rt_log_decay, w_out, w_ff1, w_ff2, final_g):
    L = x.shape[1]
    Lc = ctx.shape[1]
    rope = axial_rope(L)
    s_lat = jax.nn.silu(c)
    s_ctx = jax.nn.silu(c_ctx)[None]
    h_ctx = ctx
    for l in range(DEPTH):
        need_ctx = l < DEPTH - 1
        mx = jnp.split((s_lat @ w_mod[l] + b_mod[l])[:, None, :], N_MOD, axis=-1)
        mc = jnp.split((s_ctx @ w_mod[l] + b_mod[l])[:, None, :], N_MOD, axis=-1)
        px = modulate(rms_norm(x, norm1_g[l]), mx[0], mx[1]) @ w_in[l]
        pc = modulate(rms_norm(h_ctx, norm1_g[l]), mc[0], mc[1]) @ w_in[l]
        hy_x, ml_x, mg_x, rt_x = jnp.split(px, SPLITS, axis=-1)
        hy_c, ml_c, mg_c, rt_c = jnp.split(pc, SPLITS, axis=-1)
        filt_x = hyena_filter(L, hy_f_w1[l], hy_f_b1[l], hy_f_w2[l], hy_f_b2[l], hy_f_w3[l], hy_f_freq[l])
        y_hy = hyena_mixer(hy_x, hy_conv_w[l], filt_x, hy_bias[l])
        yc_ml, y_ml = mlstm_group(ml_c, mg_c, ml_x, mg_x, ml_conv_w[l], ml_gate_b[l], ml_norm_g[l])
        yc_rt, y_rt = retention_group(rt_c, rt_x, rt_log_decay[l], rope)
        x = x + mx[2] * (jnp.concatenate([y_hy, y_ml, y_rt], axis=-1) @ w_out[l])
        if need_ctx:
            filt_c = hyena_filter(Lc, hy_f_w1[l], hy_f_b1[l], hy_f_w2[l], hy_f_b2[l], hy_f_w3[l], hy_f_freq[l])
            yc_hy = hyena_mixer(hy_c, hy_conv_w[l], filt_c, hy_bias[l])
            h_ctx = h_ctx + mc[2] * (jnp.concatenate([yc_hy, yc_ml, yc_rt], axis=-1) @ w_out[l])
            h_ctx = h_ctx + mc[5] * sq_relu_mlp(modulate(rms_norm(h_ctx, norm2_g[l]), mc[3], mc[4]),
                                                w_ff1[l], w_ff2[l])
        x = x + mx[5] * sq_relu_mlp(modulate(rms_norm(x, norm2_g[l]), mx[3], mx[4]), w_ff1[l], w_ff2[l])
    return rms_norm(x, final_g)
```

```cpp
#include <hip/hip_runtime.h>
#include <hip/hip_cooperative_groups.h>
#include <cstdio>
namespace cg = cooperative_groups;

#define LAS __attribute__((address_space(3)))
typedef unsigned short bf16_t;
typedef short bf16x8 __attribute__((ext_vector_type(8)));
typedef float f32x4 __attribute__((ext_vector_type(4)));
typedef unsigned u32x4 __attribute__((ext_vector_type(4)));
typedef unsigned u32x2 __attribute__((ext_vector_type(2)));

constexpr int D = 2048, NB = 8, SEQ = 2048, LC = 256;
constexpr int ML_ROWS = NB * SEQ;
constexpr int MC_ROWS = NB * LC;
constexpr int MT_ROWS = ML_ROWS + MC_ROWS;
constexpr int NIN = 6928, NINP = 7168, DFF = 8192;
constexpr int C_X0 = 0, C_X1 = 512, C_HV = 1024;
constexpr int C_MLQ = 1536, C_MLK = 2304, C_MLV = 3072, C_MLO = 3840, C_G = 4608;
constexpr int C_RQ = 4624, C_RK = 5008, C_RV = 5392, C_RG = 6160;
constexpr float EPS = 1e-6f;
constexpr int NTHREADS = 512;
constexpr int LDS_BYTES = 155648;

constexpr size_t WT_LAYER = 104857600ull;
constexpr size_t WT_IN_OFF = 0, WT_OUT_OFF = 29360128ull, WT_FF1_OFF = 37748736ull, WT_FF2_OFF = 71303168ull;
constexpr size_t WS_WT = 0;
constexpr size_t WS_ACT = 209715200ull;
constexpr size_t WS_PH = WS_ACT + 75497472ull;
constexpr size_t WS_XC = WS_PH + 301989888ull;
constexpr size_t WS_OM = WS_XC + 16777216ull;
constexpr size_t OMR_DIR = (size_t)MT_ROWS * 768 * 2;
constexpr size_t WS_OR = WS_OM + 2 * OMR_DIR;
constexpr size_t WS_FX = WS_OR + 2 * OMR_DIR;
constexpr size_t WS_FC = WS_FX + 16777216ull;
constexpr size_t WS_HD = WS_FC + 1048576ull;
constexpr size_t WS_MOD = WS_HD + 1114112ull;
constexpr size_t WS_GATE = WS_MOD + 884736ull;
constexpr size_t WS_ROPE = WS_GATE + 1179648ull;
constexpr size_t WS_NORM = WS_ROPE + 786432ull;
constexpr size_t WS_CTR = WS_NORM + 34816ull;
constexpr size_t WS_BAR = WS_CTR + 256ull;
constexpr size_t WS_END = WS_BAR + 16384ull;

struct Params { const float* in[25]; float* out; unsigned char* ws; };
enum { I_X = 0, I_C, I_CTX, I_CCTX, I_N1G, I_N2G, I_WMOD, I_BMOD, I_WIN, I_HYCW, I_HW1, I_HB1, I_HW2, I_HB2, I_HW3, I_HFREQ, I_HBIAS,
       I_MLCW, I_MLGB, I_MLNG, I_RTLD, I_WOUT, I_WFF1, I_WFF2, I_FING };

typedef float f32x2_t __attribute__((ext_vector_type(2)));
typedef __bf16 bf16x2_t __attribute__((ext_vector_type(2)));
__device__ __forceinline__ unsigned cvt_pk_bf16(float lo, float hi) { f32x2_t v = {lo, hi}; bf16x2_t b = __builtin_convertvector(v, bf16x2_t); return __builtin_bit_cast(unsigned, b); }
__device__ __forceinline__ float bf_lo(unsigned u) { return __uint_as_float(u << 16); }
__device__ __forceinline__ float bf_hi(unsigned u) { return __uint_as_float(u & 0xFFFF0000u); }
__device__ __forceinline__ float bf2f(bf16_t b) { return __uint_as_float(((unsigned)b) << 16); }
__device__ __forceinline__ bf16_t f2bf(float f) { return (bf16_t)(cvt_pk_bf16(f, 0.f) & 0xFFFFu); }
__device__ __forceinline__ float siluf(float x) { return x * __builtin_amdgcn_rcpf(1.0f + __expf(-x)); }
__device__ __forceinline__ float sigmf(float x) { return __builtin_amdgcn_rcpf(1.0f + __expf(-x)); }
__device__ __forceinline__ int opaque_tid() { int t = threadIdx.x; asm volatile("" : "+v"(t)); return t; }
__device__ __forceinline__ float wave_sum(float v) {
#pragma unroll
    for (int o = 32; o > 0; o >>= 1) v += __shfl_xor(v, o);
    return v;
}
__device__ __forceinline__ void unpack8(const u32x4 v, float (&f)[8]) {
    f[0] = bf_lo(v.x); f[1] = bf_hi(v.x); f[2] = bf_lo(v.y); f[3] = bf_hi(v.y); f[4] = bf_lo(v.z); f[5] = bf_hi(v.z); f[6] = bf_lo(v.w); f[7] = bf_hi(v.w);
}
__device__ __forceinline__ u32x4 pack8(const float (&f)[8]) {
    u32x4 w; w.x = cvt_pk_bf16(f[0], f[1]); w.y = cvt_pk_bf16(f[2], f[3]); w.z = cvt_pk_bf16(f[4], f[5]); w.w = cvt_pk_bf16(f[6], f[7]); return w;
}

namespace pg8 {
constexpr int BM = 256, BK = 64, HALF = 128, HTB = HALF * BK * 2, STAGE_BYTES = 8 * HTB, NXCD = 8, WGM = 4;
__host__ __device__ __forceinline__ int lds_byte(int r, int c) { const int st = (r >> 4) * 2 + (c >> 5), rr = r & 15, cc = c & 31, ob = rr * 64 + cc * 2; return st * 1024 + (ob ^ (((ob >> 9) & 1) << 5)); }
__host__ __device__ __forceinline__ void stage_rc(int b, int& R, int& C) { const int st = b / 1024, sb = b % 1024, swz = sb ^ (((sb >> 9) & 1) << 5); R = (st >> 1) * 16 + swz / 64; C = (st & 1) * 32 + (swz % 64) / 2; }
__host__ __device__ __forceinline__ int perm32(int rho) { const int n = rho >> 4, i = rho & 15; return 8 * (i >> 2) + 4 * n + (i & 3); }
struct Unit { int pm, pn; };
struct Gemm { const bf16_t* A; const bf16_t* Bt; int M, N, K; };
struct StaticOrder {
    int nM, nN, nwg, G, c, wgm;
    __host__ __device__ void init(int M, int N, int G_, int c_, int wgm_ = WGM) { nM = M / BM; nN = N / BM; nwg = nM * nN; G = G_; c = c_; wgm = wgm_; }
    __host__ __device__ bool next(int i, Unit& u) const {
        const long L = (long)i * G + c; if (L >= nwg) return false;
        int wgid = (int)L; { const int q = nwg / NXCD, r = nwg % NXCD, xcd = wgid % NXCD, off = wgid / NXCD; wgid = (xcd < r ? xcd * (q + 1) : r * (q + 1) + (xcd - r) * q) + off; }
        const int nig = wgm * nN, gid = wgid / nig, fm = gid * wgm, gsz = (nM - fm) < wgm ? (nM - fm) : wgm;
        u.pm = fm + ((wgid % nig) % gsz); u.pn = (wgid % nig) / gsz; return true;
    }
    __device__ __forceinline__ void a_ready(const Unit&) const {}
    __device__ __forceinline__ void done(const Unit&) const {}
};

template <class Epi, class Sched>
__device__ __forceinline__ void gemm_phase(LAS unsigned char* lds, const Gemm g, const Sched& S, const Epi& E) {
    int tid_ = threadIdx.x; asm volatile("" : "+v"(tid_));
    const int tid = tid_, wid = __builtin_amdgcn_readfirstlane(tid >> 6), lane = tid & 63, wr = wid >> 2, wc = wid & 3, fr = lane & 15, fq = lane >> 4;
    const int K = g.K, nt = K / BK;
    unsigned voffA[2], voffB[2];
#pragma unroll
    for (int i = 0; i < 2; ++i) { int R, C; stage_rc(tid * 16 + i * 8192, R, C); const int Rb = Epi::PERM ? ((R & ~31) + perm32(R & 31)) : R;
        voffA[i] = (unsigned)(R * K + C) * 2u; voffB[i] = (unsigned)(Rb * K + C) * 2u; }
    const size_t kstep = (size_t)(BK * 2);
    const size_t hstep = (size_t)HALF * K * 2;
    const size_t tstep = 2 * hstep;
    const unsigned ldsw = (unsigned)wid * 1024u;
    const int aoff = lds_byte(wr * 64 + fr, fq * 8), boff = lds_byte(wc * 32 + fr, fq * 8);
#define PG8_SA(b, h) (((b) * 2 + (h)) * HTB)
#define PG8_SB(b, h) ((4 + (b) * 2 + (h)) * HTB)
#define PG8_STAGE(bufoff, gbase, voff) do { _Pragma("unroll") for (int _i = 0; _i < 2; ++_i) \
        __builtin_amdgcn_global_load_lds((const unsigned*)((const char*)(gbase) + (voff)[_i]), (LAS unsigned*)(lds + (bufoff) + ldsw + _i * 8192), 16, 0, 0); } while (0)
#define PG8_LDA(dst, b, h) do { _Pragma("unroll") for (int m = 0; m < 4; ++m) _Pragma("unroll") for (int k = 0; k < 2; ++k) dst[m][k] = *(const LAS bf16x8*)(lds + PG8_SA(b, h) + aoff + m * 2048 + k * 1024); } while (0)
#define PG8_LDB(dst, b, h) do { _Pragma("unroll") for (int n = 0; n < 2; ++n) _Pragma("unroll") for (int k = 0; k < 2; ++k) dst[n][k] = *(const LAS bf16x8*)(lds + PG8_SB(b, h) + boff + n * 2048 + k * 1024); } while (0)
#define PG8_MMA(ai, bj, At, Bt) do { __builtin_amdgcn_s_setprio(1); _Pragma("unroll") for (int m = 0; m < 4; ++m) _Pragma("unroll") for (int n = 0; n < 2; ++n) _Pragma("unroll") for (int k = 0; k < 2; ++k) \
        acc[ai][bj][m][n] = __builtin_amdgcn_mfma_f32_16x16x32_bf16(Bt[n][k], At[m][k], acc[ai][bj][m][n], 0, 0, 0); __builtin_amdgcn_s_setprio(0); } while (0)
#define PG8_WAIT_V(n) asm volatile("s_waitcnt vmcnt(" #n ")" ::: "memory")
#define PG8_WAIT_L(n) asm volatile("s_waitcnt lgkmcnt(" #n ")" ::: "memory")
#define PG8_BAR __builtin_amdgcn_s_barrier()
#define PG8_SCHED __builtin_amdgcn_sched_barrier(0)
    Unit cur, nxt; int ui = 0;
    if (!S.next(0, cur)) return;
    f32x4 acc[2][2][4][2];
#pragma unroll
    for (int a = 0; a < 2; ++a)
#pragma unroll
        for (int b = 0; b < 2; ++b)
#pragma unroll
            for (int m = 0; m < 4; ++m)
#pragma unroll
                for (int n = 0; n < 2; ++n) acc[a][b][m][n] = (f32x4){0.f, 0.f, 0.f, 0.f};
    bf16x8 At[4][2], B0[2][2], B1[2][2];
    const char* cA = (const char*)g.A + (size_t)cur.pm * tstep; const char* cB = (const char*)g.Bt + (size_t)cur.pn * tstep;
    S.a_ready(cur);
    PG8_STAGE(PG8_SB(0, 0), cB, voffB); PG8_STAGE(PG8_SA(0, 0), cA, voffA); PG8_STAGE(PG8_SB(0, 1), cB + hstep, voffB); PG8_STAGE(PG8_SA(0, 1), cA + hstep, voffA);
    if (wr == 1) PG8_BAR;
    PG8_WAIT_V(4); PG8_BAR;
    PG8_STAGE(PG8_SB(1, 0), cB + kstep, voffB); PG8_STAGE(PG8_SA(1, 0), cA + kstep, voffA); PG8_STAGE(PG8_SB(1, 1), cB + hstep + kstep, voffB);
    PG8_WAIT_V(6); PG8_BAR;
    for (;;) {
        const bool has_next = S.next(ui + 1, nxt);
        const char* nA = has_next ? (const char*)g.A + (size_t)nxt.pm * tstep : cA; const char* nB = has_next ? (const char*)g.Bt + (size_t)nxt.pn * tstep : cB;
        for (int t = 0; t < nt; t += 2) {
            const bool last = (t == nt - 2);
            const char* a1 = cA + (size_t)(t + 1) * kstep;
            const char* a2 = last ? nA : cA + (size_t)(t + 2) * kstep; const char* b2 = last ? nB : cB + (size_t)(t + 2) * kstep;
            const char* a3 = a2 + kstep; const char* b3 = b2 + kstep;
            if (last && has_next) S.a_ready(nxt);
            PG8_LDB(B0, 0, 0); PG8_SCHED; PG8_LDA(At, 0, 0); PG8_STAGE(PG8_SA(1, 1), a1 + hstep, voffA);
            PG8_WAIT_L(8); PG8_BAR; PG8_WAIT_L(0); PG8_MMA(0, 0, At, B0); PG8_BAR; PG8_SCHED;
            PG8_LDB(B1, 0, 1); PG8_STAGE(PG8_SB(0, 0), b2, voffB);
            PG8_BAR; PG8_WAIT_L(0); PG8_MMA(0, 1, At, B1); PG8_BAR;
            PG8_LDA(At, 0, 1); PG8_STAGE(PG8_SA(0, 0), a2, voffA);
            PG8_BAR; PG8_WAIT_L(0); PG8_MMA(1, 0, At, B0); PG8_BAR; PG8_SCHED;
            PG8_STAGE(PG8_SB(0, 1), b2 + hstep, voffB);
            PG8_WAIT_V(6); PG8_BAR; PG8_MMA(1, 1, At, B1); PG8_BAR;
            PG8_LDB(B0, 1, 0); PG8_SCHED; PG8_LDA(At, 1, 0); PG8_STAGE(PG8_SA(0, 1), a2 + hstep, voffA);
            PG8_WAIT_L(8); PG8_BAR; PG8_WAIT_L(0); PG8_MMA(0, 0, At, B0); PG8_BAR; PG8_SCHED;
            PG8_LDB(B1, 1, 1); PG8_STAGE(PG8_SB(1, 0), b3, voffB);
            PG8_BAR; PG8_WAIT_L(0); PG8_MMA(0, 1, At, B1); PG8_BAR;
            PG8_LDA(At, 1, 1); PG8_STAGE(PG8_SA(1, 0), a3, voffA);
            PG8_BAR; PG8_WAIT_L(0); PG8_MMA(1, 0, At, B0); PG8_BAR; PG8_SCHED;
            PG8_STAGE(PG8_SB(1, 1), b3 + hstep, voffB);
            PG8_WAIT_V(6); PG8_BAR; PG8_MMA(1, 1, At, B1); PG8_BAR;
        }
        E(acc, cur, wr, wc, fr, fq); S.done(cur);
        if (!has_next) break;
#pragma unroll
        for (int a = 0; a < 2; ++a)
#pragma unroll
            for (int b = 0; b < 2; ++b)
#pragma unroll
                for (int m = 0; m < 4; ++m)
#pragma unroll
                    for (int n = 0; n < 2; ++n) acc[a][b][m][n] = (f32x4){0.f, 0.f, 0.f, 0.f};
        cur = nxt; cA = nA; cB = nB; ++ui;
    }
    PG8_WAIT_V(0);
    if (wr == 0) PG8_BAR;
    PG8_BAR;
#undef PG8_SA
#undef PG8_SB
#undef PG8_STAGE
#undef PG8_LDA
#undef PG8_LDB
#undef PG8_MMA
#undef PG8_WAIT_V
#undef PG8_WAIT_L
#undef PG8_BAR
#undef PG8_SCHED
}
}

template <int ACT  > struct EpiBf16 {
    static constexpr bool PERM = true;
    bf16_t* O; int ldc; float* gate;
    __device__ __forceinline__ void operator()(const f32x4 (&acc)[2][2][4][2], const pg8::Unit& u, int wr, int wc, int fr, int fq) const {
        const int row0 = u.pm * 256 + wr * 64 + fr; const int col0 = u.pn * 256 + wc * 32 + 8 * fq;
#pragma unroll
        for (int ai = 0; ai < 2; ++ai)
#pragma unroll
            for (int m = 0; m < 4; ++m) { const int row = row0 + ai * 128 + m * 16; bf16_t* rowp = O + (size_t)row * ldc + col0;
#pragma unroll
                for (int bj = 0; bj < 2; ++bj) { f32x4 v0 = acc[ai][bj][m][0], v1 = acc[ai][bj][m][1];
                    if (ACT == 1) {
#pragma unroll
                        for (int j = 0; j < 4; ++j) { float a = fmaxf(v0[j], 0.f), b = fmaxf(v1[j], 0.f); v0[j] = a * a; v1[j] = b * b; } }
                    if (ACT == 0) { if (u.pn == (C_G / 256) && bj == 0 && wc == 0 && fq < 2) { float* gp = gate + (size_t)row * 16 + 8 * fq; *(f32x4*)gp = v0; *(f32x4*)(gp + 4) = v1; } }
                    u32x4 w; w.x = cvt_pk_bf16(v0[0], v0[1]); w.y = cvt_pk_bf16(v0[2], v0[3]); w.z = cvt_pk_bf16(v1[0], v1[1]); w.w = cvt_pk_bf16(v1[2], v1[3]);
                    *(u32x4*)(rowp + bj * 128) = w; } }
    }
};
struct EpiRes {
    static constexpr bool PERM = false;
    const float* xi; float* xo; const float* ci; float* co; const float* mod; int slot;
    __device__ __forceinline__ void operator()(const f32x4 (&acc)[2][2][4][2], const pg8::Unit& u, int wr, int wc, int fr, int fq) const {
        const int row0 = u.pm * 256 + wr * 64 + fr; const int col0 = u.pn * 256 + wc * 32 + 4 * fq;
#pragma unroll
        for (int ai = 0; ai < 2; ++ai)
#pragma unroll
            for (int m = 0; m < 4; ++m) { const int row = row0 + ai * 128 + m * 16;
                const float* ip; float* op; int b;
                if (row < ML_ROWS) { b = row >> 11; ip = xi + (size_t)row * D; op = xo + (size_t)row * D; }
                else { b = 8; ip = ci + (size_t)(row - ML_ROWS) * D; op = co + (size_t)(row - ML_ROWS) * D; }
                const float* gp = mod + (size_t)b * 12288 + slot * 2048;
#pragma unroll
                for (int bj = 0; bj < 2; ++bj)
#pragma unroll
                    for (int n = 0; n < 2; ++n) { const int c = col0 + bj * 128 + n * 16;
                        const f32x4 r = *(const f32x4*)(ip + c), g = *(const f32x4*)(gp + c);
                        *(f32x4*)(op + c) = r + g * acc[ai][bj][m][n]; } }
    }
};

struct WtJob { const float* W; bf16_t* WT; int K, N, kt, nt; };
__device__ __forceinline__ WtJob wt_job(const Params& p, int it) {
    constexpr int T_IN = 32 * 112, T_OUT = 32 * 32, T_FF1 = 32 * 128, T_FF2 = 128 * 32, T_L = T_IN + T_OUT + T_FF1 + T_FF2;
    const int l = it / T_L; int r = it % T_L; bf16_t* wt = (bf16_t*)(p.ws + WS_WT + (size_t)l * WT_LAYER); WtJob j;
    if (r < T_IN) { j.W = p.in[I_WIN] + (size_t)l * 2048 * NIN; j.WT = wt + WT_IN_OFF / 2; j.K = 2048; j.N = NIN; j.kt = r % 32; j.nt = r / 32; }
    else if ((r -= T_IN) < T_OUT) { j.W = p.in[I_WOUT] + (size_t)l * 2048 * 2048; j.WT = wt + WT_OUT_OFF / 2; j.K = 2048; j.N = 2048; j.kt = r % 32; j.nt = r / 32; }
    else if ((r -= T_OUT) < T_FF1) { j.W = p.in[I_WFF1] + (size_t)l * 2048 * 8192; j.WT = wt + WT_FF1_OFF / 2; j.K = 2048; j.N = 8192; j.kt = r % 32; j.nt = r / 32; }
    else { r -= T_FF1; j.W = p.in[I_WFF2] + (size_t)l * 8192 * 2048; j.WT = wt + WT_FF2_OFF / 2; j.K = 8192; j.N = 2048; j.kt = r % 128; j.nt = r / 128; }
    return j;
}
__device__ __forceinline__ void phase_prologue(const Params& p, LAS unsigned char* lds) {
    const int tid = opaque_tid(), G = gridDim.x, bid = blockIdx.x;
    unsigned char* ws = p.ws;
    { float* rc = (float*)(ws + WS_ROPE); float* rs = rc + 2048 * 48;
      for (int i = bid * NTHREADS + tid; i < 2048 * 48; i += G * NTHREADS) { const int t = i / 48, a = i % 48; const int f = a % 24;
          const float inv = powf(10000.0f, -(float)f / 24.0f); const float pos = (a < 24) ? (float)(t / 64) : (float)(t % 64); const float ang = pos * inv;
          rc[i] = cosf(ang); rs[i] = sinf(ang); } }
    { LAS float* sl = (LAS float*)lds; LAS float* red = sl + 9 * 2048;
      bool loaded = false;
      for (int item = bid; item < 384; item += G) {
          if (!loaded) { for (int i = tid; i < 9 * 2048; i += NTHREADS) { const float v = (i < 8 * 2048) ? p.in[I_C][i] : p.in[I_CCTX][i - 8 * 2048]; sl[i] = siluf(v); } loaded = true; __syncthreads(); }
          const int l = item / 192, n0 = (item % 192) * 64; const int kq = tid >> 6, col = tid & 63;
          const float* W = p.in[I_WMOD] + (size_t)l * 2048 * 12288 + n0 + col;
          float acc[9];
#pragma unroll
          for (int r = 0; r < 9; ++r) acc[r] = 0.f;
          for (int k0 = kq * 256; k0 < kq * 256 + 256; k0 += 16) { float w[16];
#pragma unroll
              for (int i = 0; i < 16; ++i) w[i] = W[(size_t)(k0 + i) * 12288];
#pragma unroll
              for (int i4 = 0; i4 < 4; ++i4)
#pragma unroll
                  for (int r = 0; r < 9; ++r) { const f32x4 s = *(const LAS f32x4*)(sl + r * 2048 + k0 + i4 * 4); acc[r] += s[0] * w[i4 * 4] + s[1] * w[i4 * 4 + 1] + s[2] * w[i4 * 4 + 2] + s[3] * w[i4 * 4 + 3]; } }
#pragma unroll
          for (int r = 0; r < 9; ++r) red[(kq * 9 + r) * 64 + col] = acc[r];
          __syncthreads();
          for (int idx = tid; idx < 576; idx += NTHREADS) { const int r = idx >> 6, cc = idx & 63; float s = 0.f;
#pragma unroll
              for (int q = 0; q < 8; ++q) s += red[(q * 9 + r) * 64 + cc];
              ((float*)(ws + WS_MOD))[((size_t)l * 9 + r) * 12288 + n0 + cc] = s + p.in[I_BMOD][l * 12288 + n0 + cc]; }
          __syncthreads();
      }
      __syncthreads();
    }
    { LAS float* z = (LAS float*)lds; LAS float* h1 = z + 8 * 36;
      for (int item = bid; item < 544; item += G) {
          int l, Ls, i0; float* HD;
          if (item < 512) { l = item >> 8; Ls = SEQ; i0 = (item & 255) * 8; HD = (float*)(ws + WS_HD) + (size_t)l * 2048 * 64; }
          else { l = 0; Ls = LC; i0 = (item - 512) * 8; HD = (float*)(ws + WS_HD) + (size_t)2 * 2048 * 64; }
          if (tid < 264) { const int pos = tid / 33, e = tid % 33; const int i = i0 + pos;
              const float t = (float)i / (float)(Ls - 1); const float w = (6.283185307179586f / (float)Ls) * (float)i; float v;
              if (e == 0) v = t; else { const int k = (e - 1) & 15; const float band = 1e-4f + (float)k * ((15.0f - 1e-4f) / 15.0f); const float a = band * w; v = (e <= 16) ? cosf(a) : -sinf(a); }
              z[pos * 36 + e] = v; }
          __syncthreads();
          const int pos = tid >> 6, j = tid & 63;
          { float s = p.in[I_HB1][l * 64 + j]; const float* w1 = p.in[I_HW1] + (size_t)l * 33 * 64 + j;
            for (int e = 0; e < 33; ++e) s += z[pos * 36 + e] * w1[e * 64];
            h1[pos * 64 + j] = sinf(p.in[I_HFREQ][l * 64 + j] * s); }
          __syncthreads();
          { float s = p.in[I_HB2][l * 64 + j]; const float* w2 = p.in[I_HW2] + (size_t)l * 64 * 64 + j;
            for (int e = 0; e < 64; ++e) s += h1[pos * 64 + e] * w2[e * 64];
            HD[(size_t)(i0 + pos) * 64 + j] = sinf(p.in[I_HFREQ][l * 64 + j] * s); }
          __syncthreads();
      }
    }
    { LAS float* tile = (LAS float*)lds;
      constexpr int T_ALL = 2 * (32 * 112 + 32 * 32 + 32 * 128 + 128 * 32);
      for (int it0 = bid * 4; it0 < T_ALL; it0 += G * 4) {
          float4 v[4][2];
#pragma unroll
          for (int q = 0; q < 4; ++q) { const WtJob j = wt_job(p, it0 + q); const int k0 = j.kt * 64, n0 = j.nt * 64;
#pragma unroll
              for (int pp = 0; pp < 2; ++pp) { const int kk = (tid >> 4) + pp * 32, n4 = (tid & 15) * 4;
                  v[q][pp] = make_float4(0.f, 0.f, 0.f, 0.f);
                  if (n0 + n4 < j.N) v[q][pp] = *(const float4*)(j.W + (size_t)(k0 + kk) * j.N + n0 + n4); } }
#pragma unroll
          for (int q = 0; q < 4; ++q)
#pragma unroll
              for (int pp = 0; pp < 2; ++pp) { const int kk = (tid >> 4) + pp * 32, n4 = (tid & 15) * 4; LAS float* t = tile + q * 64 * 65;
                  t[(n4 + 0) * 65 + kk] = v[q][pp].x; t[(n4 + 1) * 65 + kk] = v[q][pp].y; t[(n4 + 2) * 65 + kk] = v[q][pp].z; t[(n4 + 3) * 65 + kk] = v[q][pp].w; }
          __syncthreads();
#pragma unroll
          for (int q = 0; q < 4; ++q) { const WtJob j = wt_job(p, it0 + q); const int k0 = j.kt * 64, n0 = j.nt * 64; const int nn = tid >> 3, k8 = (tid & 7) * 8; float f[8];
#pragma unroll
              for (int i = 0; i < 8; ++i) f[i] = tile[q * 64 * 65 + nn * 65 + k8 + i];
              *(u32x4*)(j.WT + (size_t)(n0 + nn) * j.K + k0 + k8) = pack8(f); }
          __syncthreads();
      }
    }
}

__device__ __forceinline__ void filter_items(const Params& p, LAS unsigned char* lds, int item0, int stride) {
    const int tid = opaque_tid(); unsigned char* ws = p.ws;
    LAS float* hd = (LAS float*)lds;
    LAS float* red = hd + 256 * 64;
    for (int item = item0; item < 136; item += stride) {
        int l, cg, isl, Ls; const float* HD; float* FX; float* NP;
        if (item < 128) { l = item >> 6; cg = (item >> 3) & 7; isl = item & 7; Ls = SEQ; HD = (const float*)(ws + WS_HD) + (size_t)l * 2048 * 64; FX = (float*)(ws + WS_FX) + (size_t)l * 4096 * 512;
            NP = (float*)(ws + WS_NORM) + (size_t)(l * 8 + isl) * 512; }
        else { l = 0; cg = item - 128; isl = 0; Ls = LC; HD = (const float*)(ws + WS_HD) + (size_t)2 * 2048 * 64; FX = (float*)(ws + WS_FC); NP = (float*)(ws + WS_NORM) + (size_t)16 * 512; }
        const int i0 = isl * 256;
        __syncthreads();
        for (int i = tid; i < 256 * 64; i += NTHREADS) hd[i] = HD[(size_t)i0 * 64 + i];
        __syncthreads();
        const int c = tid & 63, dir = (tid >> 6) & 1, sub = tid >> 7; const int ch = cg * 64 + c;
        float w3[64];
        { const float* w3p = p.in[I_HW3] + (size_t)l * 64 * 1024 + dir * 512 + ch;
#pragma unroll
          for (int j = 0; j < 64; ++j) w3[j] = w3p[j * 1024]; }
        const float lo = -4.605170185988091f / 1.5f, hi = -4.605170185988091f / 0.3f;
        const float delta = fabsf(lo + (float)ch * ((hi - lo) / 511.0f));
        float asum = 0.f;
        for (int ii = 0; ii < 64; ++ii) { const int li = sub * 64 + ii; const int pos = i0 + li;
            float dot = 0.f;
#pragma unroll
            for (int j4 = 0; j4 < 16; ++j4) { const f32x4 h = *(const LAS f32x4*)(hd + li * 64 + j4 * 4);
                dot += h[0] * w3[j4 * 4] + h[1] * w3[j4 * 4 + 1] + h[2] * w3[j4 * 4 + 2] + h[3] * w3[j4 * 4 + 3]; }
            const float t = (float)pos / (float)(Ls - 1);
            const float val = dot * __expf(-t * delta);
            if (!(dir == 1 && pos == 0)) { const int lag = dir ? -pos : pos; FX[(size_t)(lag + Ls - 1) * 512 + ch] = val; asum += fabsf(val); } }
        red[(tid >> 6) * 64 + c] = asum;
        __syncthreads();
        if (tid < 64) { float s = 0.f;
#pragma unroll
            for (int q = 0; q < 8; ++q) s += red[q * 64 + tid];
            NP[cg * 64 + tid] = s; }
    }
    __syncthreads();
}

__device__ __forceinline__ void phase_norm_mod(const float* __restrict__ xl, const float* __restrict__ xc, const float* __restrict__ g, const float* __restrict__ mod, int slot_shift, int nrows, bf16_t* __restrict__ act) {
    const int tidq = opaque_tid(); const int lane = tidq & 63; const int gw = blockIdx.x * 8 + (tidq >> 6), nw = gridDim.x * 8;
    const int per = (nrows + nw - 1) / nw; const int r0 = gw * per; const int r1 = (r0 + per < nrows) ? r0 + per : nrows;
    int curb = -1; f32x4 fa[8], fb[8];
    for (int row = r0; row < r1; row += 2) {
        const bool two = row + 1 < r1; const int rowb = two ? row + 1 : row;
        const float* s0 = (row < ML_ROWS) ? xl + (size_t)row * D : xc + (size_t)(row - ML_ROWS) * D;
        const float* s1 = (rowb < ML_ROWS) ? xl + (size_t)rowb * D : xc + (size_t)(rowb - ML_ROWS) * D;
        f32x4 v0[8], v1[8]; float ss0 = 0.f, ss1 = 0.f;
#pragma unroll
        for (int i = 0; i < 8; ++i) { v0[i] = *(const f32x4*)(s0 + i * 256 + lane * 4); v1[i] = *(const f32x4*)(s1 + i * 256 + lane * 4); }
#pragma unroll
        for (int i = 0; i < 8; ++i) { ss0 += v0[i][0] * v0[i][0] + v0[i][1] * v0[i][1] + v0[i][2] * v0[i][2] + v0[i][3] * v0[i][3]; ss1 += v1[i][0] * v1[i][0] + v1[i][1] * v1[i][1] + v1[i][2] * v1[i][2] + v1[i][3] * v1[i][3]; }
        ss0 = wave_sum(ss0); ss1 = wave_sum(ss1);
#pragma unroll
        for (int h = 0; h < 2; ++h) { if (h == 1 && !two) break;
            const int rr = h ? rowb : row; const int b = (rr < ML_ROWS) ? (rr >> 11) : 8;
            if (b != curb) { curb = b; const float* sh = mod + (size_t)b * 12288 + slot_shift * 2048; const float* sc = sh + 2048;
#pragma unroll
                for (int i = 0; i < 8; ++i) { const int c = i * 256 + lane * 4; const f32x4 gg = *(const f32x4*)(g + c), s1v = *(const f32x4*)(sc + c); fb[i] = *(const f32x4*)(sh + c); fa[i] = gg * (s1v + 1.0f); } }
            const float r = rsqrtf((h ? ss1 : ss0) * (1.0f / D) + EPS);
#pragma unroll
            for (int i = 0; i < 8; ++i) { const int c = i * 256 + lane * 4; const f32x4 x = h ? v1[i] : v0[i]; const f32x4 o = (x * r) * fa[i] + fb[i];
                u32x2 w; w.x = cvt_pk_bf16(o[0], o[1]); w.y = cvt_pk_bf16(o[2], o[3]);
                *(u32x2*)(act + (size_t)rr * D + c) = w; } }
    }
}

__device__ __forceinline__ void phase_qk(const Params& p, int l) {
    const int tidq = opaque_tid(); unsigned char* ws = p.ws;
    const bf16_t* P = (const bf16_t*)(ws + WS_PH); bf16_t* QK = (bf16_t*)(ws + WS_ACT) + 512;
    const float* cw = p.in[I_MLCW] + (size_t)l * 3 * 1536;
    const int nunits = (MT_ROWS / 4) * 192;
    const bool xmap = (gridDim.x % 8 == 0) && (gridDim.x >= 8);
    const int nloc = xmap ? (SEQ + LC) / 4 * 192 : nunits;
    const int lthreads = xmap ? (gridDim.x >> 3) * NTHREADS : gridDim.x * NTHREADS; const int lfirst = xmap ? (blockIdx.x >> 3) * NTHREADS + tidq : blockIdx.x * NTHREADS + tidq;
    for (int uu = lfirst; uu < nloc; uu += lthreads) { int u = uu;
        if (xmap) { const int bx = blockIdx.x & 7; const int cgx = uu % 192, rb = uu / 192;
            const int rowblk = (rb < SEQ / 4) ? (bx * (SEQ / 4) + rb) : (ML_ROWS / 4 + bx * (LC / 4) + (rb - SEQ / 4)); u = rowblk * 192 + cgx; }
        const int cg = u % 192, r0 = (u / 192) * 4; const int c0 = cg * 8;
        const int seg_lo = (r0 < ML_ROWS) ? (r0 & ~2047) : (ML_ROWS + ((r0 - ML_ROWS) & ~255)); const int seg_hi = seg_lo + ((r0 < ML_ROWS) ? SEQ : LC);
        u32x4 raw[6];
#pragma unroll
        for (int t = 0; t < 6; ++t) { const int row = r0 - 1 + t; raw[t] = (row >= seg_lo && row < seg_hi) ? *(const u32x4*)(P + (size_t)row * NINP + C_MLQ + c0) : (u32x4){0u, 0u, 0u, 0u}; }
        float w0[8], w1[8], w2[8];
#pragma unroll
        for (int i = 0; i < 8; ++i) { w0[i] = cw[c0 + i]; w1[i] = cw[1536 + c0 + i]; w2[i] = cw[3072 + c0 + i]; }
        const float sc = (c0 >= 768) ? 0.07216878364870322f : 1.0f;
#pragma unroll
        for (int rr = 0; rr < 4; ++rr) { float xa[8], xb[8], xc[8], o[8]; unpack8(raw[rr], xa); unpack8(raw[rr + 1], xb); unpack8(raw[rr + 2], xc);
#pragma unroll
            for (int i = 0; i < 8; ++i) { const float v = w0[i] * xa[i] + w1[i] * xb[i] + w2[i] * xc[i]; o[i] = siluf(v) * sc; }
            *(u32x4*)(QK + (size_t)(r0 + rr) * D + c0) = pack8(o); } }
}

__device__ __forceinline__ f32x4 mfma16(const bf16x8 a, const bf16x8 b, const f32x4 c) { return __builtin_amdgcn_mfma_f32_16x16x32_bf16(a, b, c, 0, 0, 0); }

template <int DK, int NT, bool IS_ML>
__device__ __forceinline__ void scan_chain(const Params& p, int l, int item, LAS unsigned char* lds) {
    constexpr int LDQ = DK + 8, LDS2 = 136, LDC = DK + 8, KS = DK / 32, DPG = IS_ML ? 6 : 3, CG8 = DK / 8;
    constexpr int R0B = (128 * LDQ * 2 > 128 * LDS2 * 2) ? 128 * LDQ * 2 : 128 * LDS2 * 2;
    constexpr int R1B = (128 * LDQ * 2 > DK * LDS2 * 2) ? 128 * LDQ * 2 : DK * LDS2 * 2;
    constexpr int R2B = NT * 16 * LDS2 * 2, R3B = NT * 16 * LDC * 2;
    constexpr int NKR = (128 * CG8 + NTHREADS - 1) / NTHREADS;
    LAS bf16_t* Qs = (LAS bf16_t*)lds;
    LAS bf16_t* Ks = (LAS bf16_t*)(lds + R0B);
    LAS bf16_t* Vt = (LAS bf16_t*)(lds + R0B + R1B);
    LAS bf16_t* Ct = (LAS bf16_t*)(lds + R0B + R1B + R2B);
    LAS float* vec = (LAS float*)(lds + R0B + R1B + R2B + R3B);
    LAS float* colterm = vec; LAS float* rowterm = vec + 128; LAS float* winter = vec + 256; LAS float* wkv = vec + 384; LAS float* oscale = vec + 512; LAS float* scal = vec + 640;
    static_assert(R0B + R1B + R2B + R3B + 656 * 4 <= LDS_BYTES - 64, "LDS");

    int tid_ = threadIdx.x; asm volatile("" : "+v"(tid_));
    const int tid = tid_, wid = __builtin_amdgcn_readfirstlane(tid >> 6), lane = tid & 63, fr = lane & 15, fq = lane >> 4;
    const int sl = item & 3, dir = (item >> 2) & 1, h = (item >> 3) & 3, b = item >> 5;
    unsigned char* ws = p.ws;
    const bf16_t* P = (const bf16_t*)(ws + WS_PH);
    bf16_t* OUT = (bf16_t*)(ws + (IS_ML ? WS_OM : WS_OR) + (size_t)dir * OMR_DIR);
    const float* GATE = (const float*)(ws + WS_GATE);
    const float* ropec = (const float*)(ws + WS_ROPE); const float* ropes = ropec + 2048 * 48;

    __syncthreads();
    for (int i = tid; i < NT * 16 * LDC / 2; i += NTHREADS) ((LAS unsigned*)Ct)[i] = 0u;
    if (IS_ML) { for (int u = tid; u < 16 * 128; u += NTHREADS) { const int e = 48 + (u >> 7), j = u & 127; Vt[e * LDS2 + j] = (e == 48) ? (bf16_t)0x3F80 : (bf16_t)0; } }
    if (!IS_ML) { const float lg = -__expf(p.in[I_RTLD][l * 8 + dir * 4 + h]);
        if (tid < 128) { const float j = (float)tid; colterm[tid] = __expf(-lg * j); rowterm[tid] = __expf(lg * j); winter[tid] = __expf(lg * (j + 1.0f)); wkv[tid] = __expf(lg * (127.0f - j)); oscale[tid] = 0.f; }
        if (tid == 0) { scal[0] = __expf(lg * 128.0f); scal[1] = 0.f; } }
    if (IS_ML && tid == 0) { float one = 1.0f, zero = 0.f; asm volatile("" : "+v"(one), "+v"(zero)); scal[0] = one; scal[1] = zero; }
    f32x4 accC[DPG];
#pragma unroll
    for (int i = 0; i < DPG; ++i) accC[i] = (f32x4){0.f, 0.f, 0.f, 0.f};
    float gbi = 0.f, gbf = 0.f;
    if (IS_ML) { gbi = p.in[I_MLGB][l * 16 + dir * 8 + h]; gbf = p.in[I_MLGB][l * 16 + dir * 8 + 4 + h]; }
    __syncthreads();

    const int tid_chain = tid;
    for (int step = 0; step < 18; ++step) {
        int tq_ = tid_chain; asm volatile("" : "+v"(tq_));
        const int tid = tq_, wid = __builtin_amdgcn_readfirstlane(tid >> 6), lane = tid & 63, fr = lane & 15, fq = lane >> 4;
        const bool isctx = step < 2; const int nch = isctx ? 2 : 16; const int ci = isctx ? step : step - 2; const int chunk = dir ? (nch - 1 - ci) : ci;
        const int seg_lo = isctx ? (ML_ROWS + b * LC) : b * SEQ; const int seg_hi = seg_lo + (isctx ? LC : SEQ);
        const int rowbase = seg_lo + chunk * 128;
        u32x4 vreg[2]; float g_i = 0.f, g_f = 0.f;
        { const int vc = (IS_ML ? C_MLV : C_RV) + h * 192 + sl * 48;
#pragma unroll
          for (int k = 0; k < 2; ++k) { const int u = tid + k * NTHREADS; vreg[k] = (u32x4){0u, 0u, 0u, 0u};
              if (u < 128 * 6) { const int j = u & 127, e0 = (u >> 7) * 8; const int row = dir ? rowbase + 127 - j : rowbase + j; vreg[k] = *(const u32x4*)(P + (size_t)row * NINP + vc + e0); } }
          if (IS_ML && tid < 128) { const int row = dir ? rowbase + 127 - tid : rowbase + tid; g_i = GATE[(size_t)row * 16 + dir * 8 + h]; g_f = GATE[(size_t)row * 16 + dir * 8 + 4 + h]; } }
        if (IS_ML) {
            { const bf16_t* QK = (const bf16_t*)(ws + WS_ACT) + 512 + h * 192; u32x4 raw[12];
#pragma unroll
              for (int k = 0; k < 12; ++k) { const int u = tid + k * NTHREADS; const int cgq = u % 48, rch = u / 48; raw[k] = *(const u32x4*)(QK + (size_t)(rowbase + rch) * D + ((cgq >= 24) ? 768 : 0) + (cgq % 24) * 8); }
#pragma unroll
              for (int k = 0; k < 12; ++k) { const int u = tid + k * NTHREADS; const int cgq = u % 48, rch = u / 48; const int j = dir ? 127 - rch : rch;
                  *(LAS u32x4*)(((cgq >= 24) ? Ks : Qs) + j * LDQ + (cgq % 24) * 8) = raw[k]; } }
        } else {
            for (int u = tid; u < 128 * 6; u += NTHREADS) { const int j = u / 6, d0 = (u % 6) * 8; const int row = dir ? rowbase + 127 - j : rowbase + j;
                float cs[8], sn[8];
                if (!isctx) { const int t = row - seg_lo;
#pragma unroll
                    for (int i = 0; i < 8; ++i) { cs[i] = ropec[t * 48 + d0 + i]; sn[i] = ropes[t * 48 + d0 + i]; } }
                else {
#pragma unroll
                    for (int i = 0; i < 8; ++i) { cs[i] = 1.f; sn[i] = 0.f; } }
#pragma unroll
                for (int qk = 0; qk < 2; ++qk) { const int pc = (qk ? C_RK : C_RQ) + h * 96 + d0; const bf16_t* pr = P + (size_t)row * NINP + pc;
                    float a1[8], a2[8], o1[8], o2[8]; unpack8(*(const u32x4*)pr, a1); unpack8(*(const u32x4*)(pr + 48), a2);
                    const float sc = qk ? 1.0f : 0.10206207261596575f;
#pragma unroll
                    for (int i = 0; i < 8; ++i) { o1[i] = (a1[i] * cs[i] - a2[i] * sn[i]) * sc; o2[i] = (a1[i] * sn[i] + a2[i] * cs[i]) * sc; }
                    LAS bf16_t* dst = (qk ? Ks : Qs) + j * LDQ + d0;
                    *(LAS u32x4*)dst = pack8(o1); *(LAS u32x4*)(dst + 48) = pack8(o2); } }
        }
#pragma unroll
        for (int k = 0; k < 2; ++k) { const int u = tid + k * NTHREADS; if (u < 128 * 6) { const int j = u & 127, e0 = (u >> 7) * 8; const u32x4 v = vreg[k];
              Vt[(e0 + 0) * LDS2 + j] = (bf16_t)(v.x & 0xFFFFu); Vt[(e0 + 1) * LDS2 + j] = (bf16_t)(v.x >> 16);
              Vt[(e0 + 2) * LDS2 + j] = (bf16_t)(v.y & 0xFFFFu); Vt[(e0 + 3) * LDS2 + j] = (bf16_t)(v.y >> 16);
              Vt[(e0 + 4) * LDS2 + j] = (bf16_t)(v.z & 0xFFFFu); Vt[(e0 + 5) * LDS2 + j] = (bf16_t)(v.z >> 16);
              Vt[(e0 + 6) * LDS2 + j] = (bf16_t)(v.w & 0xFFFFu); Vt[(e0 + 7) * LDS2 + j] = (bf16_t)(v.w >> 16); } }
        if (IS_ML) { if (tid < 128) { colterm[tid] = g_i + gbi; const float gf = g_f + gbf; rowterm[tid] = fminf(gf, 0.f) - log1pf(__expf(-fabsf(gf))); } }
        __syncthreads();
        if (IS_ML) {
            if (wid == 0) {
                const float mprev = scal[1];
                const int j0 = 2 * lane, j1 = j0 + 1;
                const float i0 = colterm[j0], i1 = colterm[j1], f0 = rowterm[j0], f1 = rowterm[j1];
                float s = f0 + f1;
#pragma unroll
                for (int o = 1; o < 64; o <<= 1) { const float t = __shfl_up(s, o); if (lane >= o) s += t; }
                const float excl = s - (f0 + f1);
                const float b0 = excl + f0, b1 = excl + f0 + f1;
                const float a0 = i0 - b0, a1 = i1 - b1;
                float mx = fmaxf(a0, a1);
#pragma unroll
                for (int o = 1; o < 64; o <<= 1) { const float t = __shfl_up(mx, o); if (lane >= o) mx = fmaxf(mx, t); }
                float exm = __shfl_up(mx, 1); if (lane == 0) exm = -3.0e38f;
                const float M0 = fmaxf(fmaxf(mprev, exm), a0), M1 = fmaxf(M0, a1);
                const float Mlast = __shfl(M1, 63); const float bend = __shfl(b1, 63);
                colterm[j0] = a0; colterm[j1] = a1; rowterm[j0] = M0; rowterm[j1] = M1;
                winter[j0] = __expf(mprev - M0); winter[j1] = __expf(mprev - M1);
                wkv[j0] = __expf(a0 - Mlast); wkv[j1] = __expf(a1 - Mlast);
                oscale[j0] = __expf(-(b0 + M0)); oscale[j1] = __expf(-(b1 + M1));
                if (lane == 0) { scal[0] = __expf(mprev - Mlast); scal[1] = bend + Mlast; }
            }
            __syncthreads();
        }
        const float decay = scal[0];
        const int tt = (wid < 4) ? wid : 11 - wid;
        const int trow = 16 * tt + fr;
        bf16x8 qf[KS];
#pragma unroll
        for (int ks = 0; ks < KS; ++ks) qf[ks] = *(const LAS bf16x8*)(Qs + trow * LDQ + ks * 32 + fq * 8);
        f32x4 accO[NT];
        { bf16x8 cf[2][KS];
#pragma unroll
          for (int ks = 0; ks < KS; ++ks) cf[0][ks] = *(const LAS bf16x8*)(Ct + fr * LDC + ks * 32 + fq * 8);
#pragma unroll
          for (int nt = 0; nt < NT; ++nt) { accO[nt] = (f32x4){0.f, 0.f, 0.f, 0.f};
              if (nt + 1 < NT) {
#pragma unroll
                  for (int ks = 0; ks < KS; ++ks) cf[(nt + 1) & 1][ks] = *(const LAS bf16x8*)(Ct + (16 * (nt + 1) + fr) * LDC + ks * 32 + fq * 8); }
#pragma unroll
              for (int ks = 0; ks < KS; ++ks) accO[nt] = mfma16(cf[nt & 1][ks], qf[ks], accO[nt]); } }
        { const float wi = winter[trow];
#pragma unroll
          for (int nt = 0; nt < NT; ++nt) accO[nt] *= wi; }
        f32x4 accS[8];
        { bf16x8 kf[2][KS];
#pragma unroll
          for (int ks = 0; ks < KS; ++ks) kf[0][ks] = *(const LAS bf16x8*)(Ks + fr * LDQ + ks * 32 + fq * 8);
#pragma unroll
          for (int ns = 0; ns < 8; ++ns) { accS[ns] = (f32x4){0.f, 0.f, 0.f, 0.f};
              if (ns <= tt) {
                  if (ns + 1 <= tt && ns + 1 < 8) {
#pragma unroll
                      for (int ks = 0; ks < KS; ++ks) kf[(ns + 1) & 1][ks] = *(const LAS bf16x8*)(Ks + (16 * (ns + 1) + fr) * LDQ + ks * 32 + fq * 8); }
#pragma unroll
                  for (int ks = 0; ks < KS; ++ks) accS[ns] = mfma16(kf[ns & 1][ks], qf[ks], accS[ns]); } } }
        u32x4 kreg[NKR];
#pragma unroll
        for (int q = 0; q < NKR; ++q) { const int u = tid + q * NTHREADS; if (u < 128 * CG8) { const int j = u & 127, d0 = (u >> 7) * 8; kreg[q] = *(const LAS u32x4*)(Ks + j * LDQ + d0); } else kreg[q] = (u32x4){0u, 0u, 0u, 0u}; }
        __syncthreads();
        { const float rt = rowterm[trow];
#pragma unroll
          for (int ns = 0; ns < 8; ++ns) { u32x2 w = (u32x2){0u, 0u};
              if (ns <= tt) { float v[4]; const f32x4 ct = *(const LAS f32x4*)(colterm + 16 * ns + fq * 4);
#pragma unroll
                  for (int jj = 0; jj < 4; ++jj) { const int s = 16 * ns + fq * 4 + jj; const float e = (IS_ML ? __expf(fminf(ct[jj] - rt, 0.f)) : ct[jj] * rt) * ((s <= trow) ? 1.0f : 0.0f); v[jj] = accS[ns][jj] * e; }
                  w.x = cvt_pk_bf16(v[0], v[1]); w.y = cvt_pk_bf16(v[2], v[3]); }
              *(LAS u32x2*)(Qs + trow * LDS2 + 16 * ns + fq * 4) = w; } }
#pragma unroll
        for (int q = 0; q < NKR; ++q) { const int u = tid + q * NTHREADS; if (u < 128 * CG8) { const int j = u & 127, d0 = (u >> 7) * 8; float f[8]; unpack8(kreg[q], f); const float wk = wkv[j];
#pragma unroll
                for (int i = 0; i < 8; ++i) Ks[(d0 + i) * LDS2 + j] = f2bf(f[i] * wk); } }
        __syncthreads();
#pragma unroll
        for (int ks = 0; ks < 4; ++ks) { if (ks * 2 <= tt) { const bf16x8 sf = *(const LAS bf16x8*)(Qs + trow * LDS2 + ks * 32 + fq * 8);
#pragma unroll
                for (int nt = 0; nt < NT; ++nt) { const bf16x8 vf = *(const LAS bf16x8*)(Vt + (16 * nt + fr) * LDS2 + ks * 32 + fq * 8); accO[nt] = mfma16(vf, sf, accO[nt]); } } }
        { float inv = 1.0f;
          if (IS_ML) { const float den = __shfl(accO[NT - 1][0], fr); inv = 1.0f / fmaxf(fabsf(den), oscale[trow]); }
          const int row = dir ? rowbase + 127 - trow : rowbase + trow;
          bf16_t* op = OUT + ((size_t)(h * 4 + sl) * MT_ROWS + row) * 48 + fq * 4;
#pragma unroll
          for (int nt = 0; nt < 3; ++nt) { u32x2 w; w.x = cvt_pk_bf16(accO[nt][0] * inv, accO[nt][1] * inv); w.y = cvt_pk_bf16(accO[nt][2] * inv, accO[nt][3] * inv); *(u32x2*)(op + nt * 16) = w; } }
        if (wid < 2 * NT) { const int et = wid % NT, grp = wid / NT;
            bf16x8 vf4[4];
#pragma unroll
            for (int ks = 0; ks < 4; ++ks) vf4[ks] = *(const LAS bf16x8*)(Vt + (16 * et + fr) * LDS2 + ks * 32 + fq * 8);
            bf16x8 kw[2][4];
#pragma unroll
            for (int ks = 0; ks < 4; ++ks) kw[0][ks] = *(const LAS bf16x8*)(Ks + (16 * (grp * DPG) + fr) * LDS2 + ks * 32 + fq * 8);
#pragma unroll
            for (int dt = 0; dt < DPG; ++dt) { const int dtile = grp * DPG + dt; accC[dt] *= decay;
                if (dt + 1 < DPG) {
#pragma unroll
                    for (int ks = 0; ks < 4; ++ks) kw[(dt + 1) & 1][ks] = *(const LAS bf16x8*)(Ks + (16 * (dtile + 1) + fr) * LDS2 + ks * 32 + fq * 8); }
#pragma unroll
                for (int ks = 0; ks < 4; ++ks) accC[dt] = mfma16(kw[dt & 1][ks], vf4[ks], accC[dt]);
                u32x2 w; w.x = cvt_pk_bf16(accC[dt][0], accC[dt][1]); w.y = cvt_pk_bf16(accC[dt][2], accC[dt][3]);
                *(LAS u32x2*)(Ct + (16 * et + fr) * LDC + 16 * dtile + fq * 4) = w; } }
        __syncthreads();
    }
}

template <int LS>
__device__ __forceinline__ void hyena_item(const Params& p, int l, int b, int cg, int tb, bool isctx, LAS unsigned char* lds) {
    const int tid_ = opaque_tid();
    const int lane = tid_ & 63, wid = __builtin_amdgcn_readfirstlane(tid_ >> 6); unsigned char* ws = p.ws;
    LAS float* zs = (LAS float*)lds;
    LAS float* fs = zs + 64 * 64;
    const int ch = cg * 64 + lane; const int seg_lo = isctx ? (ML_ROWS + b * LC) : b * SEQ;
    const bf16_t* Pb = (const bf16_t*)(ws + WS_PH) + (size_t)seg_lo * NINP + cg * 64;
    bf16_t* Yb = (bf16_t*)(ws + WS_ACT) + (size_t)seg_lo * D + cg * 64;
    const float* FX = (isctx ? (const float*)(ws + WS_FC) : (const float*)(ws + WS_FX) + (size_t)l * 4096 * 512) + cg * 64;
    const float* NP = isctx ? (const float*)(ws + WS_NORM) + 16 * 512 : (const float*)(ws + WS_NORM) + (size_t)l * 8 * 512;
    const float* cw = p.in[I_HYCW] + (size_t)l * 3 * 1536;
    const float wx0a = cw[C_X0 + ch], wx0b = cw[1536 + C_X0 + ch], wx0c = cw[3072 + C_X0 + ch];
    const float wx1a = cw[C_X1 + ch], wx1b = cw[1536 + C_X1 + ch], wx1c = cw[3072 + C_X1 + ch];
    const float wva = cw[C_HV + ch], wvb = cw[1536 + C_HV + ch], wvc = cw[3072 + C_HV + ch];
    const int tblk = tb * 256, t0 = tblk + wid * 32;
    float acc[32];
#pragma unroll
    for (int i = 0; i < 32; ++i) acc[i] = 0.f;
    for (int sc = 0; sc < LS; sc += 64) {
        __syncthreads();
        { const int s8 = sc + wid * 8; const bf16_t* ps = Pb + (size_t)s8 * NINP;
          float pv0 = (s8 > 0) ? bf2f(ps[-NINP + C_HV + lane]) : 0.f, px0 = (s8 > 0) ? bf2f(ps[-NINP + C_X1 + lane]) : 0.f;
          float pv1 = bf2f(ps[C_HV + lane]), px1 = bf2f(ps[C_X1 + lane]);
#pragma unroll
          for (int k = 0; k < 8; ++k) { float pv2 = 0.f, px2 = 0.f;
              if (s8 + k + 1 < LS) { pv2 = bf2f(ps[(k + 1) * NINP + C_HV + lane]); px2 = bf2f(ps[(k + 1) * NINP + C_X1 + lane]); }
              zs[(wid * 8 + k) * 64 + lane] = (wva * pv0 + wvb * pv1 + wvc * pv2) * (wx1a * px0 + wx1b * px1 + wx1c * px2);
              pv0 = pv1; pv1 = pv2; px0 = px1; px1 = px2; } }
        { const int jlo = tblk - sc - 63 + LS - 1;
#pragma unroll 8
          for (int r = wid; r < 319; r += 8) { const int j = jlo + r; fs[r * 64 + lane] = (j >= 0 && j <= 2 * LS - 2) ? FX[(size_t)j * 512 + lane] : 0.f; } }
        __syncthreads();
#pragma unroll 1
        for (int kb = 0; kb < 4; ++kb) {
            float z[16], f[47];
            const int rb = wid * 32 + 48 - kb * 16;
#pragma unroll
            for (int k = 0; k < 16; ++k) z[k] = zs[(kb * 16 + k) * 64 + lane];
#pragma unroll
            for (int i = 0; i < 47; ++i) f[i] = fs[(rb + i) * 64 + lane];
#pragma unroll
            for (int k = 0; k < 16; ++k) {
#pragma unroll
                for (int i = 0; i < 32; ++i) acc[i] += f[15 + i - k] * z[k]; }
        }
    }
    float nsum = 0.f;
    if (isctx) nsum = NP[ch]; else {
#pragma unroll
        for (int q = 0; q < 8; ++q) nsum += NP[q * 512 + ch]; }
    const float inv = 1.0f / nsum; const float bias = p.in[I_HBIAS][l * 512 + ch];
    { const bf16_t* pt = Pb + (size_t)t0 * NINP;
      float m0 = 0.f, m1 = 0.f, m2 = 0.f;
      if (t0 > 0) { m0 = bf2f(pt[-NINP + C_X0 + lane]); m1 = bf2f(pt[-NINP + C_X1 + lane]); m2 = bf2f(pt[-NINP + C_HV + lane]); }
      float a0 = bf2f(pt[C_X0 + lane]), a1 = bf2f(pt[C_X1 + lane]), a2 = bf2f(pt[C_HV + lane]);
#pragma unroll
      for (int i = 0; i < 32; ++i) { float q0 = 0.f, q1 = 0.f, q2 = 0.f;
          if (t0 + i + 1 < LS) { q0 = bf2f(pt[(i + 1) * NINP + C_X0 + lane]); q1 = bf2f(pt[(i + 1) * NINP + C_X1 + lane]); q2 = bf2f(pt[(i + 1) * NINP + C_HV + lane]); }
          const float x0 = wx0a * m0 + wx0b * a0 + wx0c * q0; const float x1 = wx1a * m1 + wx1b * a1 + wx1c * q1; const float vv = wva * m2 + wvb * a2 + wvc * q2;
          const float zt = vv * x1; const float y = (acc[i] * inv + bias * zt) * x0;
          Yb[(size_t)(t0 + i) * D + lane] = f2bf(y);
          m0 = a0; m1 = a1; m2 = a2; a0 = q0; a1 = q1; a2 = q2;
          if ((i & 7) == 7) asm volatile("" ::: "memory"); } }
}

__device__ __forceinline__ void hyena_mfma(const Params& p, int l, int item, LAS unsigned char* lds) {
    constexpr int ZLD = 2056, GLD = 4104;
    const int tid = opaque_tid(); const int lane = tid & 63, wid = __builtin_amdgcn_readfirstlane(tid >> 6), r = lane & 15, q = lane >> 4;
    unsigned char* ws = p.ws;
    LAS bf16_t* ZS = (LAS bf16_t*)lds;
    LAS bf16_t* GS = ZS + 2 * 8 * ZLD;
    const int c0 = item * 2;
    const bf16_t* P = (const bf16_t*)(ws + WS_PH); bf16_t* Y = (bf16_t*)(ws + WS_ACT);
    const float* FX = (const float*)(ws + WS_FX) + (size_t)l * 4096 * 512;
    const float* NP = (const float*)(ws + WS_NORM) + (size_t)l * 8 * 512;
    const float* cw = p.in[I_HYCW] + (size_t)l * 3 * 1536;
    __syncthreads();
    { const int b = tid >> 6, s0 = (tid & 63) * 32;
      float wv[2][3], wx[2][3];
#pragma unroll
      for (int c = 0; c < 2; ++c)
#pragma unroll
          for (int t = 0; t < 3; ++t) { wv[c][t] = cw[t * 1536 + C_HV + c0 + c]; wx[c][t] = cw[t * 1536 + C_X1 + c0 + c]; }
      const bf16_t* pb = P + (size_t)(b * SEQ) * NINP + c0;
      unsigned vr[34], xr_[34];
#pragma unroll
      for (int k = 0; k < 34; ++k) { const int s = s0 - 1 + k; const bool ok = (s >= 0) && (s < SEQ);
          vr[k] = ok ? *(const unsigned*)(pb + (size_t)s * NINP + C_HV) : 0u; xr_[k] = ok ? *(const unsigned*)(pb + (size_t)s * NINP + C_X1) : 0u; }
#pragma unroll
      for (int g = 0; g < 4; ++g) { float za[8], zb[8];
#pragma unroll
          for (int k = 0; k < 8; ++k) { const int i = g * 8 + k; const unsigned v0 = vr[i], v1 = vr[i + 1], v2 = vr[i + 2], x0 = xr_[i], x1 = xr_[i + 1], x2 = xr_[i + 2];
              za[k] = (wv[0][0] * bf_lo(v0) + wv[0][1] * bf_lo(v1) + wv[0][2] * bf_lo(v2)) * (wx[0][0] * bf_lo(x0) + wx[0][1] * bf_lo(x1) + wx[0][2] * bf_lo(x2));
              zb[k] = (wv[1][0] * bf_hi(v0) + wv[1][1] * bf_hi(v1) + wv[1][2] * bf_hi(v2)) * (wx[1][0] * bf_hi(x0) + wx[1][1] * bf_hi(x1) + wx[1][2] * bf_hi(x2)); }
          *(LAS u32x4*)(ZS + (0 * 8 + b) * ZLD + s0 + g * 8) = pack8(za);
          *(LAS u32x4*)(ZS + (1 * 8 + b) * ZLD + s0 + g * 8) = pack8(zb); } }
    f32x4 acc[16];
    const int t0 = wid * 256;
#pragma unroll 1
    for (int c = 0; c < 2; ++c) {
        const int ch = c0 + c;
        __syncthreads();
        { float nsum = 0.f;
#pragma unroll
          for (int qq = 0; qq < 8; ++qq) nsum += NP[qq * 512 + ch];
          const float inv = 1.0f / nsum; const float bias = p.in[I_HBIAS][l * 512 + ch];
#pragma unroll
          for (int i = 0; i < 8; ++i) { const int m = tid + i * 512; float g = 0.f;
              if (m <= 4094) { g = FX[(size_t)(4094 - m) * 512 + ch] * inv; if (m == 2047) g += bias; }
              const bf16_t gb = f2bf(g);
#pragma unroll
              for (int k = 0; k < 8; ++k) { if (m - k >= 0) GS[k * GLD + (m - k)] = gb; } }
        }
        __syncthreads();
        const int kc = (7 - r) & 7;
        const LAS bf16_t* gp = GS + kc * GLD + (2047 - t0 - r + 8 * q - kc);
        const LAS bf16_t* zp = ZS + (c * 8 + (lane & 7)) * ZLD + 8 * q;
        bf16x8 ring[16];
#pragma unroll
        for (int i = 0; i < 16; ++i) { acc[i] = (f32x4){0.f, 0.f, 0.f, 0.f}; ring[i] = *(const LAS bf16x8*)(gp - 16 * i); }
        bf16x8 zf = *(const LAS bf16x8*)zp;
#pragma unroll 1
        for (int J = 0; J < 8; ++J) {
#pragma unroll
            for (int jj = 0; jj < 8; ++jj) { const int j = J * 8 + jj;
                bf16x8 rn0 = zf, rn1 = zf, zn = zf;
                if (j + 1 < 64) { rn0 = *(const LAS bf16x8*)(gp + 16 * (2 * (j + 1))); rn1 = *(const LAS bf16x8*)(gp + 16 * (2 * (j + 1) - 1)); zn = *(const LAS bf16x8*)(zp + 32 * (j + 1)); }
#pragma unroll
                for (int i = 0; i < 16; ++i) acc[i] = mfma16(ring[(i - 2 * jj) & 15], zf, acc[i]);
                if (j + 1 < 64) { ring[(16 - 2 * (jj + 1)) & 15] = rn0; ring[(17 - 2 * (jj + 1)) & 15] = rn1; }
                zf = zn; } }
        __syncthreads();
        if (r < 8) { LAS bf16_t* yb_ = ZS + (c * 8 + r) * ZLD + t0 + 4 * q;
#pragma unroll
            for (int i = 0; i < 16; ++i) { u32x2 w; w.x = cvt_pk_bf16(acc[i][0], acc[i][1]); w.y = cvt_pk_bf16(acc[i][2], acc[i][3]); *(LAS u32x2*)(yb_ + 16 * i) = w; } }
    }
    __syncthreads();
    { const int b = tid >> 6;
      float w0[3], w1[3];
#pragma unroll
      for (int t = 0; t < 3; ++t) { w0[t] = cw[t * 1536 + C_X0 + c0]; w1[t] = cw[t * 1536 + C_X0 + c0 + 1]; }
      const bf16_t* pb = P + (size_t)(b * SEQ) * NINP + C_X0 + c0; bf16_t* yb = Y + (size_t)(b * SEQ) * D + c0;
      unsigned xall[8][6];
#pragma unroll
      for (int k = 0; k < 8; ++k) { const int tb = 4 * (tid & 63) + 256 * k;
#pragma unroll
          for (int u = 0; u < 6; ++u) { const int t = tb - 1 + u; xall[k][u] = (t >= 0 && t < SEQ) ? *(const unsigned*)(pb + (size_t)t * NINP) : 0u; } }
#pragma unroll
      for (int k = 0; k < 8; ++k) { const int tb = 4 * (tid & 63) + 256 * k;
          const unsigned* xr = xall[k];
          const u32x2 ya = *(const LAS u32x2*)(ZS + (0 * 8 + b) * ZLD + tb), yc = *(const LAS u32x2*)(ZS + (1 * 8 + b) * ZLD + tb);
          const float y0[4] = {bf_lo(ya.x), bf_hi(ya.x), bf_lo(ya.y), bf_hi(ya.y)}, y1[4] = {bf_lo(yc.x), bf_hi(yc.x), bf_lo(yc.y), bf_hi(yc.y)};
#pragma unroll
          for (int jj = 0; jj < 4; ++jj) {
              const float xa = w0[0] * bf_lo(xr[jj]) + w0[1] * bf_lo(xr[jj + 1]) + w0[2] * bf_lo(xr[jj + 2]);
              const float xb = w1[0] * bf_hi(xr[jj]) + w1[1] * bf_hi(xr[jj + 1]) + w1[2] * bf_hi(xr[jj + 2]);
              *(unsigned*)(yb + (size_t)(tb + jj) * D) = cvt_pk_bf16(y0[jj] * xa, y1[jj] * xb); } } }
    __syncthreads();
}

__device__ __forceinline__ void phase_mixers(const Params& p, int l, LAS unsigned char* lds) {
    const int G = gridDim.x, bid = blockIdx.x;
    const int vb = (G % 8 == 0) ? (bid & 7) * (G >> 3) + (bid >> 3) : bid;
    for (int item = vb; item < 256; item += G) scan_chain<192, 4, true>(p, l, item, lds);
    for (int item = vb; item < 256; item += G) scan_chain<96, 3, false>(p, l, item, lds);
    for (int item = vb; item < 256; item += G) hyena_mfma(p, l, item, lds);
    if (l == 0) { for (int item = G - 1 - bid; item < 64; item += G) hyena_item<LC>(p, l, item >> 3, item & 7, 0, true, lds); }
}

__device__ __forceinline__ void phase_combine(const Params& p, int l, int nrows) {
    const int tidq = opaque_tid(); unsigned char* ws = p.ws; const int lane = tidq & 63; const int gw = blockIdx.x * 8 + (tidq >> 6), nw = gridDim.x * 8;
    const bf16_t* P = (const bf16_t*)(ws + WS_PH); bf16_t* Y = (bf16_t*)(ws + WS_ACT);
    const float* ng = p.in[I_MLNG] + (size_t)l * 768;
    const int li = lane & 31, e0 = 6 * li, sl = li >> 3, ee = 6 * (li & 7);
    for (int u = gw; u < nrows * 4; u += nw) { const int row = u >> 2, grp = (u >> 1) & 1, h = (u & 1) * 2 + (lane >> 5);
        const bf16_t* o0 = (const bf16_t*)(ws + (grp ? WS_OR : WS_OM)) + ((size_t)(h * 4 + sl) * MT_ROWS + row) * 48 + ee; const bf16_t* o1 = o0 + OMR_DIR / 2;
        const bf16_t* gp = P + (size_t)row * NINP + (grp ? C_RG : C_MLO) + h * 192 + e0;
        unsigned a[3], c[3], gt[3];
#pragma unroll
        for (int i = 0; i < 3; ++i) { a[i] = ((const unsigned*)o0)[i]; c[i] = ((const unsigned*)o1)[i]; gt[i] = ((const unsigned*)gp)[i]; }
        float v[6]; float ss = 0.f;
#pragma unroll
        for (int i = 0; i < 3; ++i) { v[2 * i] = bf_lo(a[i]) + bf_lo(c[i]); v[2 * i + 1] = bf_hi(a[i]) + bf_hi(c[i]); ss += v[2 * i] * v[2 * i] + v[2 * i + 1] * v[2 * i + 1]; }
#pragma unroll
        for (int o = 16; o > 0; o >>= 1) ss += __shfl_xor(ss, o);
        const float r = rsqrtf(ss * (1.0f / 192.0f) + EPS);
        float y[6];
#pragma unroll
        for (int i = 0; i < 6; ++i) { const float g = (i & 1) ? bf_hi(gt[i >> 1]) : bf_lo(gt[i >> 1]);
            y[i] = grp ? (v[i] * r * siluf(g)) : (v[i] * r * ng[h * 192 + e0 + i] * sigmf(g)); }
        unsigned* yp = (unsigned*)(Y + (size_t)row * D + (grp ? 1280 : 512) + h * 192 + e0);
#pragma unroll
        for (int i = 0; i < 3; ++i) yp[i] = cvt_pk_bf16(y[2 * i], y[2 * i + 1]); }
}

__device__ __forceinline__ void phase_final(const Params& p) {
    const int tidq = opaque_tid(); const int lane = tidq & 63; const int gw = blockIdx.x * 8 + (tidq >> 6), nw = gridDim.x * 8;
    const float* g = p.in[I_FING];
    const int per = (ML_ROWS + nw - 1) / nw; const int r0 = gw * per; const int r1 = (r0 + per < ML_ROWS) ? r0 + per : ML_ROWS;
    f32x4 gg[8];
#pragma unroll
    for (int i = 0; i < 8; ++i) gg[i] = *(const f32x4*)(g + i * 256 + lane * 4);
    for (int row = r0; row < r1; row += 2) { const bool two = row + 1 < r1; float* s0 = p.out + (size_t)row * D; float* s1 = p.out + (size_t)(two ? row + 1 : row) * D;
        f32x4 v0[8], v1[8]; float ss0 = 0.f, ss1 = 0.f;
#pragma unroll
        for (int i = 0; i < 8; ++i) { v0[i] = *(const f32x4*)(s0 + i * 256 + lane * 4); v1[i] = *(const f32x4*)(s1 + i * 256 + lane * 4); }
#pragma unroll
        for (int i = 0; i < 8; ++i) { ss0 += v0[i][0] * v0[i][0] + v0[i][1] * v0[i][1] + v0[i][2] * v0[i][2] + v0[i][3] * v0[i][3]; ss1 += v1[i][0] * v1[i][0] + v1[i][1] * v1[i][1] + v1[i][2] * v1[i][2] + v1[i][3] * v1[i][3]; }
        ss0 = wave_sum(ss0); ss1 = wave_sum(ss1);
        const float ra = rsqrtf(ss0 * (1.0f / D) + EPS), rb = rsqrtf(ss1 * (1.0f / D) + EPS);
#pragma unroll
        for (int i = 0; i < 8; ++i) { const int c = i * 256 + lane * 4; *(f32x4*)(s0 + c) = v0[i] * ra * gg[i]; if (two) *(f32x4*)(s1 + c) = v1[i] * rb * gg[i]; } }
}

#define XB_TMO      128
#define XB_XCNT(j)  (256  + 64 * (j))
#define XB_XSUB(j)  (1280 + 64 * (j))
#define XB_XGEN(j)  (2304 + 64 * (j))
#define XB_TOP      3328
#define XB_TOPGEN   3392
#define XCD_BAR_WORDS 3456
#define XB_SPIN_CAP (1u << 22)
__device__ __forceinline__ unsigned xb_ld(unsigned* p)              { return __hip_atomic_load(p, __ATOMIC_RELAXED, __HIP_MEMORY_SCOPE_AGENT); }
__device__ __forceinline__ unsigned xb_add(unsigned* p, unsigned v) { return __hip_atomic_fetch_add(p, v, __ATOMIC_RELAXED, __HIP_MEMORY_SCOPE_AGENT); }
__device__ __forceinline__ unsigned xb_xcc_id() { return (unsigned)__builtin_amdgcn_s_getreg((3 << 11) | 20) & 0xFu; }
#define XB_SPIN(cond, bar) do { unsigned _sp = 0; while (cond) { __builtin_amdgcn_s_sleep(1); \
    if ((++_sp & 255u) == 0u) { if (xb_ld(&(bar)[XB_TMO])) break; if (_sp > XB_SPIN_CAP) { atomicAdd(&(bar)[XB_TMO], 1u); break; } } } } while (0)
struct XcdBarrier { unsigned* bar; volatile LAS unsigned* st; };
__device__ __forceinline__ XcdBarrier xcd_barrier_post(unsigned* bar, volatile LAS unsigned* st) {
    XcdBarrier b; b.bar = bar; b.st = st; const unsigned x = (unsigned)__builtin_amdgcn_readfirstlane((int)xb_xcc_id());
    if (threadIdx.x == 0) (void)xb_add(&bar[XB_XCNT(x)], 1u);
    return b;
}
__device__ __forceinline__ void xcd_barrier_complete(unsigned* bar, unsigned x, unsigned& nloc, unsigned& nx) {
    const unsigned G = gridDim.x * gridDim.y * gridDim.z;
    unsigned sum, cnt, mine, sp = 0u;
    for (;;) {
        sum = 0u; cnt = 0u; mine = 0u;
#pragma unroll
        for (unsigned j = 0; j < 16; ++j) { const unsigned c = xb_ld(&bar[XB_XCNT(j)]); sum += c; cnt += (c > 0u) ? 1u : 0u; mine = (j == x) ? c : mine; }
        if (sum == G) break;
        __builtin_amdgcn_s_sleep(1);
        if ((++sp & 255u) == 0u) { if (xb_ld(&bar[XB_TMO])) break; if (sp > XB_SPIN_CAP) { atomicAdd(&bar[XB_TMO], 1u); break; } }
    }
    nloc = mine > 0u ? mine : 1u; nx = cnt > 0u ? cnt : 1u;
}
__device__ __forceinline__ void xcd_barrier(const XcdBarrier& b) {
    asm volatile("s_waitcnt vmcnt(0)" ::: "memory");
    __syncthreads();
    if (threadIdx.x == 0) {
        unsigned* bar = b.bar; const unsigned bx = (unsigned)__builtin_amdgcn_readfirstlane((int)xb_xcc_id());
        __builtin_amdgcn_s_waitcnt(0);
        unsigned nloc = b.st[0], nx = b.st[1];
        if (nloc == 0u) { xcd_barrier_complete(bar, bx, nloc, nx); b.st[0] = nloc; b.st[1] = nx; }
        const unsigned old = xb_add(&bar[XB_XSUB(bx)], 1u);
        const unsigned gen = old / nloc;
        if (old + 1u == (gen + 1u) * nloc) {
            __builtin_amdgcn_fence(__ATOMIC_RELEASE, "agent");
            asm volatile("s_waitcnt vmcnt(0)" ::: "memory");
            const unsigned og = xb_add(&bar[XB_TOP], 1u);
            const unsigned tg = og / nx;
            if (og + 1u == (tg + 1u) * nx) xb_add(&bar[XB_TOPGEN], 1u);
            else XB_SPIN(xb_ld(&bar[XB_TOPGEN]) == tg, bar);
            __builtin_amdgcn_fence(__ATOMIC_ACQUIRE, "agent");
            xb_add(&bar[XB_XGEN(bx)], 1u);
            asm volatile("s_waitcnt vmcnt(0)" ::: "memory");
        } else {
            XB_SPIN(xb_ld(&bar[XB_XGEN(bx)]) == gen, bar);
            __builtin_amdgcn_fence(__ATOMIC_ACQUIRE, "agent");
            asm volatile("s_waitcnt vmcnt(0)" ::: "memory");
        }
    }
    __syncthreads();
}

#ifndef WGM_IN
#define WGM_IN 8
#define WGM_OUT 4
#define WGM_FF1 8
#define WGM_FF2 4
#endif
__global__ void __launch_bounds__(NTHREADS, 2) mk_fwd(Params p) {
    extern __shared__ __attribute__((aligned(16))) unsigned char lds_raw[];
    LAS unsigned char* lds = (LAS unsigned char*)lds_raw;
    cg::grid_group grid = cg::this_grid();
    unsigned char* ws = p.ws; const int G = gridDim.x, bid = blockIdx.x;
    bf16_t* ACT = (bf16_t*)(ws + WS_ACT); bf16_t* PH = (bf16_t*)(ws + WS_PH); float* XC = (float*)(ws + WS_XC);

    volatile LAS unsigned* bst = (volatile LAS unsigned*)(lds + LDS_BYTES - 32);
    if (threadIdx.x == 0) { bst[0] = 0u; bst[1] = 0u; }
    __syncthreads();
    const XcdBarrier xb = xcd_barrier_post((unsigned*)(ws + WS_BAR), bst);
    grid.sync();
    phase_prologue(p, lds);
    xcd_barrier(xb);
#pragma nounroll
    for (int l = 0; l < 2; ++l) {
        const float* mod = (const float*)(ws + WS_MOD) + (size_t)l * 9 * 12288;
        const bf16_t* wt = (const bf16_t*)(ws + WS_WT + (size_t)l * WT_LAYER);
        const float* xin = l == 0 ? p.in[I_X] : p.out; const float* cin = l == 0 ? p.in[I_CTX] : XC;
        if (l == 0) filter_items(p, lds, G - 1 - bid, G);
        phase_norm_mod(xin, cin, p.in[I_N1G] + l * D, mod, 0, MT_ROWS, ACT);
        xcd_barrier(xb);
        { pg8::StaticOrder S; S.init(MT_ROWS, NINP, G, bid, WGM_IN); EpiBf16<0> E{PH, NINP, (float*)(ws + WS_GATE)};
          pg8::gemm_phase(lds, pg8::Gemm{ACT, wt + WT_IN_OFF / 2, MT_ROWS, NINP, D}, S, E); }
        xcd_barrier(xb);
        phase_qk(p, l);
        xcd_barrier(xb);
        phase_mixers(p, l, lds);
        xcd_barrier(xb);
        phase_combine(p, l, l == 0 ? MT_ROWS : ML_ROWS);
        xcd_barrier(xb);
        const int Mr = l == 0 ? MT_ROWS : ML_ROWS;
        { pg8::StaticOrder S; S.init(Mr, D, G, bid, WGM_OUT); EpiRes E{xin, p.out, cin, XC, mod, 2};
          pg8::gemm_phase(lds, pg8::Gemm{ACT, wt + WT_OUT_OFF / 2, Mr, D, D}, S, E); }
        xcd_barrier(xb);
        phase_norm_mod(p.out, XC, p.in[I_N2G] + l * D, mod, 3, Mr, ACT);
        xcd_barrier(xb);
        { pg8::StaticOrder S; S.init(Mr, DFF, G, bid, WGM_FF1); EpiBf16<1> E{PH, DFF, nullptr};
          pg8::gemm_phase(lds, pg8::Gemm{ACT, wt + WT_FF1_OFF / 2, Mr, DFF, D}, S, E); }
        xcd_barrier(xb);
        { pg8::StaticOrder S; S.init(Mr, D, G, bid, WGM_FF2); EpiRes E{p.out, p.out, XC, XC, mod, 5};
          pg8::gemm_phase(lds, pg8::Gemm{PH, wt + WT_FF2_OFF / 2, Mr, D, DFF}, S, E); }
        xcd_barrier(xb);
    }
    phase_final(p);
}

extern "C" void kernel_launch(void* const* d_in, const int* in_sizes, int n_in, void* d_out, int out_size, void* d_ws, size_t ws_size, hipStream_t stream) {
    static int grid = 0;
    if (!grid) {
        int dev = 0, cus = 0, per_cu = 0;
        (void)hipGetDevice(&dev);
        (void)hipDeviceGetAttribute(&cus, hipDeviceAttributeMultiprocessorCount, dev);
        (void)hipFuncSetAttribute((const void*)mk_fwd, hipFuncAttributeMaxDynamicSharedMemorySize, LDS_BYTES);
        (void)hipOccupancyMaxActiveBlocksPerMultiprocessor(&per_cu, (const void*)mk_fwd, NTHREADS, LDS_BYTES);
        if (per_cu < 1) per_cu = 1;
        grid = cus * per_cu;
        if (ws_size < WS_END || n_in != 25) { fprintf(stderr, "kernel_launch: workspace %zu < %zu or n_in %d != 25\n", ws_size, (size_t)WS_END, n_in); }
    }
    (void)hipMemsetAsync((unsigned char*)d_ws + WS_BAR, 0, 16384, stream);
    Params p{};
    for (int i = 0; i < 25; ++i) p.in[i] = (const float*)d_in[i];
    p.out = (float*)d_out; p.ws = (unsigned char*)d_ws;
    void* args[] = {&p};
    hipError_t e = hipLaunchCooperativeKernel((const void*)mk_fwd, dim3(grid), dim3(NTHREADS), args, LDS_BYTES, stream);
    if (e != hipSuccess) fprintf(stderr, "cooperative launch failed: %s (grid %d)\n", hipGetErrorString(e), grid);
}
```

```cpp
#include <hip/hip_runtime.h>
#include <hip/hip_cooperative_groups.h>
#include <cstdio>
namespace cg = cooperative_groups;

#define LAS __attribute__((address_space(3)))
typedef unsigned short bf16_t;
typedef short bf16x8 __attribute__((ext_vector_type(8)));
typedef float f32x4 __attribute__((ext_vector_type(4)));
typedef unsigned u32x4 __attribute__((ext_vector_type(4)));
typedef unsigned u32x2 __attribute__((ext_vector_type(2)));

constexpr int D = 2048, NB = 8, SEQ = 2048, LC = 256;
constexpr int ML_ROWS = NB * SEQ;
constexpr int MC_ROWS = NB * LC;
constexpr int MT_ROWS = ML_ROWS + MC_ROWS;
constexpr int NIN = 6928, NINP = 7168, DFF = 8192;
constexpr int C_X0 = 0, C_X1 = 512, C_HV = 1024;
constexpr int C_MLQ = 1536, C_MLK = 2304, C_MLV = 3072, C_MLO = 3840, C_G = 4608;
constexpr int C_RQ = 4624, C_RK = 5008, C_RV = 5392, C_RG = 6160;
constexpr float EPS = 1e-6f;
constexpr int NTHREADS = 512;
constexpr int LDS_BYTES = 155648;

constexpr size_t WT_LAYER = 104857600ull;
constexpr size_t WT_IN_OFF = 0, WT_OUT_OFF = 29360128ull, WT_FF1_OFF = 37748736ull, WT_FF2_OFF = 71303168ull;
constexpr size_t WS_WT = 0;
constexpr size_t WS_ACT = 209715200ull;
constexpr size_t WS_PH = WS_ACT + 75497472ull;
constexpr size_t WS_XC = WS_PH + 301989888ull;
constexpr size_t WS_OM = WS_XC + 16777216ull;
constexpr size_t OMR_DIR = (size_t)MT_ROWS * 768 * 2;
constexpr size_t WS_OR = WS_OM + 2 * OMR_DIR;
constexpr size_t WS_FX = WS_OR + 2 * OMR_DIR;
constexpr size_t WS_FC = WS_FX + 16777216ull;
constexpr size_t WS_HD = WS_FC + 1048576ull;
constexpr size_t WS_MOD = WS_HD + 1114112ull;
constexpr size_t WS_GATE = WS_MOD + 884736ull;
constexpr size_t WS_ROPE = WS_GATE + 1179648ull;
constexpr size_t WS_NORM = WS_ROPE + 786432ull;
constexpr size_t WS_CTR = WS_NORM + 34816ull;
constexpr size_t WS_BAR = WS_CTR + 256ull;
constexpr size_t WS_END = WS_BAR + 16384ull;

struct Params { const float* in[25]; float* out; unsigned char* ws; };
enum { I_X = 0, I_C, I_CTX, I_CCTX, I_N1G, I_N2G, I_WMOD, I_BMOD, I_WIN, I_HYCW, I_HW1, I_HB1, I_HW2, I_HB2, I_HW3, I_HFREQ, I_HBIAS,
       I_MLCW, I_MLGB, I_MLNG, I_RTLD, I_WOUT, I_WFF1, I_WFF2, I_FING };

typedef float f32x2_t __attribute__((ext_vector_type(2)));
typedef __bf16 bf16x2_t __attribute__((ext_vector_type(2)));
__device__ __forceinline__ unsigned cvt_pk_bf16(float lo, float hi) { f32x2_t v = {lo, hi}; bf16x2_t b = __builtin_convertvector(v, bf16x2_t); return __builtin_bit_cast(unsigned, b); }
__device__ __forceinline__ float bf_lo(unsigned u) { return __uint_as_float(u << 16); }
__device__ __forceinline__ float bf_hi(unsigned u) { return __uint_as_float(u & 0xFFFF0000u); }
__device__ __forceinline__ float bf2f(bf16_t b) { return __uint_as_float(((unsigned)b) << 16); }
__device__ __forceinline__ bf16_t f2bf(float f) { return (bf16_t)(cvt_pk_bf16(f, 0.f) & 0xFFFFu); }
__device__ __forceinline__ float siluf(float x) { return x * __builtin_amdgcn_rcpf(1.0f + __expf(-x)); }
__device__ __forceinline__ float sigmf(float x) { return __builtin_amdgcn_rcpf(1.0f + __expf(-x)); }
__device__ __forceinline__ int opaque_tid() { int t = threadIdx.x; asm volatile("" : "+v"(t)); return t; }
__device__ __forceinline__ float wave_sum(float v) {
#pragma unroll
    for (int o = 32; o > 0; o >>= 1) v += __shfl_xor(v, o);
    return v;
}
__device__ __forceinline__ void unpack8(const u32x4 v, float (&f)[8]) {
    f[0] = bf_lo(v.x); f[1] = bf_hi(v.x); f[2] = bf_lo(v.y); f[3] = bf_hi(v.y); f[4] = bf_lo(v.z); f[5] = bf_hi(v.z); f[6] = bf_lo(v.w); f[7] = bf_hi(v.w);
}
__device__ __forceinline__ u32x4 pack8(const float (&f)[8]) {
    u32x4 w; w.x = cvt_pk_bf16(f[0], f[1]); w.y = cvt_pk_bf16(f[2], f[3]); w.z = cvt_pk_bf16(f[4], f[5]); w.w = cvt_pk_bf16(f[6], f[7]); return w;
}

namespace pg8 {
constexpr int BM = 256, BK = 64, HALF = 128, HTB = HALF * BK * 2, STAGE_BYTES = 8 * HTB, NXCD = 8, WGM = 4;
__host__ __device__ __forceinline__ int lds_byte(int r, int c) { const int st = (r >> 4) * 2 + (c >> 5), rr = r & 15, cc = c & 31, ob = rr * 64 + cc * 2; return st * 1024 + (ob ^ (((ob >> 9) & 1) << 5)); }
__host__ __device__ __forceinline__ void stage_rc(int b, int& R, int& C) { const int st = b / 1024, sb = b % 1024, swz = sb ^ (((sb >> 9) & 1) << 5); R = (st >> 1) * 16 + swz / 64; C = (st & 1) * 32 + (swz % 64) / 2; }
__host__ __device__ __forceinline__ int perm32(int rho) { const int n = rho >> 4, i = rho & 15; return 8 * (i >> 2) + 4 * n + (i & 3); }
struct Unit { int pm, pn; };
struct Gemm { const bf16_t* A; const bf16_t* Bt; int M, N, K; };
struct StaticOrder {
    int nM, nN, nwg, G, c, wgm;
    __host__ __device__ void init(int M, int N, int G_, int c_, int wgm_ = WGM) { nM = M / BM; nN = N / BM; nwg = nM * nN; G = G_; c = c_; wgm = wgm_; }
    __host__ __device__ bool next(int i, Unit& u) const {
        const long L = (long)i * G + c; if (L >= nwg) return false;
        int wgid = (int)L; { const int q = nwg / NXCD, r = nwg % NXCD, xcd = wgid % NXCD, off = wgid / NXCD; wgid = (xcd < r ? xcd * (q + 1) : r * (q + 1) + (xcd - r) * q) + off; }
        const int nig = wgm * nN, gid = wgid / nig, fm = gid * wgm, gsz = (nM - fm) < wgm ? (nM - fm) : wgm;
        u.pm = fm + ((wgid % nig) % gsz); u.pn = (wgid % nig) / gsz; return true;
    }
    __device__ __forceinline__ void a_ready(const Unit&) const {}
    __device__ __forceinline__ void done(const Unit&) const {}
};

template <class Epi, class Sched>
__device__ __forceinline__ void gemm_phase(LAS unsigned char* lds, const Gemm g, const Sched& S, const Epi& E) {
    int tid_ = threadIdx.x; asm volatile("" : "+v"(tid_));
    const int tid = tid_, wid = __builtin_amdgcn_readfirstlane(tid >> 6), lane = tid & 63, wr = wid >> 2, wc = wid & 3, fr = lane & 15, fq = lane >> 4;
    const int K = g.K, nt = K / BK;
    unsigned voffA[2], voffB[2];
#pragma unroll
    for (int i = 0; i < 2; ++i) { int R, C; stage_rc(tid * 16 + i * 8192, R, C); const int Rb = Epi::PERM ? ((R & ~31) + perm32(R & 31)) : R;
        voffA[i] = (unsigned)(R * K + C) * 2u; voffB[i] = (unsigned)(Rb * K + C) * 2u; }
    const size_t kstep = (size_t)(BK * 2);
    const size_t hstep = (size_t)HALF * K * 2;
    const size_t tstep = 2 * hstep;
    const unsigned ldsw = (unsigned)wid * 1024u;
    const int aoff = lds_byte(wr * 64 + fr, fq * 8), boff = lds_byte(wc * 32 + fr, fq * 8);
#define PG8_SA(b, h) (((b) * 2 + (h)) * HTB)
#define PG8_SB(b, h) ((4 + (b) * 2 + (h)) * HTB)
#define PG8_STAGE(bufoff, gbase, voff) do { _Pragma("unroll") for (int _i = 0; _i < 2; ++_i) \
        __builtin_amdgcn_global_load_lds((const unsigned*)((const char*)(gbase) + (voff)[_i]), (LAS unsigned*)(lds + (bufoff) + ldsw + _i * 8192), 16, 0, 0); } while (0)
#define PG8_LDA(dst, b, h) do { _Pragma("unroll") for (int m = 0; m < 4; ++m) _Pragma("unroll") for (int k = 0; k < 2; ++k) dst[m][k] = *(const LAS bf16x8*)(lds + PG8_SA(b, h) + aoff + m * 2048 + k * 1024); } while (0)
#define PG8_LDB(dst, b, h) do { _Pragma("unroll") for (int n = 0; n < 2; ++n) _Pragma("unroll") for (int k = 0; k < 2; ++k) dst[n][k] = *(const LAS bf16x8*)(lds + PG8_SB(b, h) + boff + n * 2048 + k * 1024); } while (0)
#define PG8_MMA(ai, bj, At, Bt) do { __builtin_amdgcn_s_setprio(1); _Pragma("unroll") for (int m = 0; m < 4; ++m) _Pragma("unroll") for (int n = 0; n < 2; ++n) _Pragma("unroll") for (int k = 0; k < 2; ++k) \
        acc[ai][bj][m][n] = __builtin_amdgcn_mfma_f32_16x16x32_bf16(Bt[n][k], At[m][k], acc[ai][bj][m][n], 0, 0, 0); __builtin_amdgcn_s_setprio(0); } while (0)
#define PG8_WAIT_V(n) asm volatile("s_waitcnt vmcnt(" #n ")" ::: "memory")
#define PG8_WAIT_L(n) asm volatile("s_waitcnt lgkmcnt(" #n ")" ::: "memory")
#define PG8_BAR __builtin_amdgcn_s_barrier()
#define PG8_SCHED __builtin_amdgcn_sched_barrier(0)
    Unit cur, nxt; int ui = 0;
    if (!S.next(0, cur)) return;
    f32x4 acc[2][2][4][2];
#pragma unroll
    for (int a = 0; a < 2; ++a)
#pragma unroll
        for (int b = 0; b < 2; ++b)
#pragma unroll
            for (int m = 0; m < 4; ++m)
#pragma unroll
                for (int n = 0; n < 2; ++n) acc[a][b][m][n] = (f32x4){0.f, 0.f, 0.f, 0.f};
    bf16x8 At[4][2], B0[2][2], B1[2][2];
    const char* cA = (const char*)g.A + (size_t)cur.pm * tstep; const char* cB = (const char*)g.Bt + (size_t)cur.pn * tstep;
    S.a_ready(cur);
    PG8_STAGE(PG8_SB(0, 0), cB, voffB); PG8_STAGE(PG8_SA(0, 0), cA, voffA); PG8_STAGE(PG8_SB(0, 1), cB + hstep, voffB); PG8_STAGE(PG8_SA(0, 1), cA + hstep, voffA);
    if (wr == 1) PG8_BAR;
    PG8_WAIT_V(4); PG8_BAR;
    PG8_STAGE(PG8_SB(1, 0), cB + kstep, voffB); PG8_STAGE(PG8_SA(1, 0), cA + kstep, voffA); PG8_STAGE(PG8_SB(1, 1), cB + hstep + kstep, voffB);
    PG8_WAIT_V(6); PG8_BAR;
    for (;;) {
        const bool has_next = S.next(ui + 1, nxt);
        const char* nA = has_next ? (const char*)g.A + (size_t)nxt.pm * tstep : cA; const char* nB = has_next ? (const char*)g.Bt + (size_t)nxt.pn * tstep : cB;
        for (int t = 0; t < nt; t += 2) {
            const bool last = (t == nt - 2);
            const char* a1 = cA + (size_t)(t + 1) * kstep;
            const char* a2 = last ? nA : cA + (size_t)(t + 2) * kstep; const char* b2 = last ? nB : cB + (size_t)(t + 2) * kstep;
            const char* a3 = a2 + kstep; const char* b3 = b2 + kstep;
            if (last && has_next) S.a_ready(nxt);
            PG8_LDB(B0, 0, 0); PG8_SCHED; PG8_LDA(At, 0, 0); PG8_STAGE(PG8_SA(1, 1), a1 + hstep, voffA);
            PG8_WAIT_L(8); PG8_BAR; PG8_WAIT_L(0); PG8_MMA(0, 0, At, B0); PG8_BAR; PG8_SCHED;
            PG8_LDB(B1, 0, 1); PG8_STAGE(PG8_SB(0, 0), b2, voffB);
            PG8_BAR; PG8_WAIT_L(0); PG8_MMA(0, 1, At, B1); PG8_BAR;
            PG8_LDA(At, 0, 1); PG8_STAGE(PG8_SA(0, 0), a2, voffA);
            PG8_BAR; PG8_WAIT_L(0); PG8_MMA(1, 0, At, B0); PG8_BAR; PG8_SCHED;
            PG8_STAGE(PG8_SB(0, 1), b2 + hstep, voffB);
            PG8_WAIT_V(6); PG8_BAR; PG8_MMA(1, 1, At, B1); PG8_BAR;
            PG8_LDB(B0, 1, 0); PG8_SCHED; PG8_LDA(At, 1, 0); PG8_STAGE(PG8_SA(0, 1), a2 + hstep, voffA);
            PG8_WAIT_L(8); PG8_BAR; PG8_WAIT_L(0); PG8_MMA(0, 0, At, B0); PG8_BAR; PG8_SCHED;
            PG8_LDB(B1, 1, 1); PG8_STAGE(PG8_SB(1, 0), b3, voffB);
            PG8_BAR; PG8_WAIT_L(0); PG8_MMA(0, 1, At, B1); PG8_BAR;
            PG8_LDA(At, 1, 1); PG8_STAGE(PG8_SA(1, 0), a3, voffA);
            PG8_BAR; PG8_WAIT_L(0); PG8_MMA(1, 0, At, B0); PG8_BAR; PG8_SCHED;
            PG8_STAGE(PG8_SB(1, 1), b3 + hstep, voffB);
            PG8_WAIT_V(6); PG8_BAR; PG8_MMA(1, 1, At, B1); PG8_BAR;
        }
        E(acc, cur, wr, wc, fr, fq); S.done(cur);
        if (!has_next) break;
#pragma unroll
        for (int a = 0; a < 2; ++a)
#pragma unroll
            for (int b = 0; b < 2; ++b)
#pragma unroll
                for (int m = 0; m < 4; ++m)
#pragma unroll
                    for (int n = 0; n < 2; ++n) acc[a][b][m][n] = (f32x4){0.f, 0.f, 0.f, 0.f};
        cur = nxt; cA = nA; cB = nB; ++ui;
    }
    PG8_WAIT_V(0);
    if (wr == 0) PG8_BAR;
    PG8_BAR;
#undef PG8_SA
#undef PG8_SB
#undef PG8_STAGE
#undef PG8_LDA
#undef PG8_LDB
#undef PG8_MMA
#undef PG8_WAIT_V
#undef PG8_WAIT_L
#undef PG8_BAR
#undef PG8_SCHED
}
}

template <int ACT  > struct EpiBf16 {
    static constexpr bool PERM = true;
    bf16_t* O; int ldc; float* gate;
    __device__ __forceinline__ void operator()(const f32x4 (&acc)[2][2][4][2], const pg8::Unit& u, int wr, int wc, int fr, int fq) const {
        const int row0 = u.pm * 256 + wr * 64 + fr; const int col0 = u.pn * 256 + wc * 32 + 8 * fq;
#pragma unroll
        for (int ai = 0; ai < 2; ++ai)
#pragma unroll
            for (int m = 0; m < 4; ++m) { const int row = row0 + ai * 128 + m * 16; bf16_t* rowp = O + (size_t)row * ldc + col0;
#pragma unroll
                for (int bj = 0; bj < 2; ++bj) { f32x4 v0 = acc[ai][bj][m][0], v1 = acc[ai][bj][m][1];
                    if (ACT == 1) {
#pragma unroll
                        for (int j = 0; j < 4; ++j) { float a = fmaxf(v0[j], 0.f), b = fmaxf(v1[j], 0.f); v0[j] = a * a; v1[j] = b * b; } }
                    if (ACT == 0) { if (u.pn == (C_G / 256) && bj == 0 && wc == 0 && fq < 2) { float* gp = gate + (size_t)row * 16 + 8 * fq; *(f32x4*)gp = v0; *(f32x4*)(gp + 4) = v1; } }
                    u32x4 w; w.x = cvt_pk_bf16(v0[0], v0[1]); w.y = cvt_pk_bf16(v0[2], v0[3]); w.z = cvt_pk_bf16(v1[0], v1[1]); w.w = cvt_pk_bf16(v1[2], v1[3]);
                    *(u32x4*)(rowp + bj * 128) = w; } }
    }
};
struct EpiRes {
    static constexpr bool PERM = false;
    const float* xi; float* xo; const float* ci; float* co; const float* mod; int slot;
    __device__ __forceinline__ void operator()(const f32x4 (&acc)[2][2][4][2], const pg8::Unit& u, int wr, int wc, int fr, int fq) const {
        const int row0 = u.pm * 256 + wr * 64 + fr; const int col0 = u.pn * 256 + wc * 32 + 4 * fq;
#pragma unroll
        for (int ai = 0; ai < 2; ++ai)
#pragma unroll
            for (int m = 0; m < 4; ++m) { const int row = row0 + ai * 128 + m * 16;
                const float* ip; float* op; int b;
                if (row < ML_ROWS) { b = row >> 11; ip = xi + (size_t)row * D; op = xo + (size_t)row * D; }
                else { b = 8; ip = ci + (size_t)(row - ML_ROWS) * D; op = co + (size_t)(row - ML_ROWS) * D; }
                const float* gp = mod + (size_t)b * 12288 + slot * 2048;
#pragma unroll
                for (int bj = 0; bj < 2; ++bj)
#pragma unroll
                    for (int n = 0; n < 2; ++n) { const int c = col0 + bj * 128 + n * 16;
                        const f32x4 r = *(const f32x4*)(ip + c), g = *(const f32x4*)(gp + c);
                        *(f32x4*)(op + c) = r + g * acc[ai][bj][m][n]; } }
    }
};

struct WtJob { const float* W; bf16_t* WT; int K, N, kt, nt; };
__device__ __forceinline__ WtJob wt_job(const Params& p, int it) {
    constexpr int T_IN = 32 * 112, T_OUT = 32 * 32, T_FF1 = 32 * 128, T_FF2 = 128 * 32, T_L = T_IN + T_OUT + T_FF1 + T_FF2;
    const int l = it / T_L; int r = it % T_L; bf16_t* wt = (bf16_t*)(p.ws + WS_WT + (size_t)l * WT_LAYER); WtJob j;
    if (r < T_IN) { j.W = p.in[I_WIN] + (size_t)l * 2048 * NIN; j.WT = wt + WT_IN_OFF / 2; j.K = 2048; j.N = NIN; j.kt = r % 32; j.nt = r / 32; }
    else if ((r -= T_IN) < T_OUT) { j.W = p.in[I_WOUT] + (size_t)l * 2048 * 2048; j.WT = wt + WT_OUT_OFF / 2; j.K = 2048; j.N = 2048; j.kt = r % 32; j.nt = r / 32; }
    else if ((r -= T_OUT) < T_FF1) { j.W = p.in[I_WFF1] + (size_t)l * 2048 * 8192; j.WT = wt + WT_FF1_OFF / 2; j.K = 2048; j.N = 8192; j.kt = r % 32; j.nt = r / 32; }
    else { r -= T_FF1; j.W = p.in[I_WFF2] + (size_t)l * 8192 * 2048; j.WT = wt + WT_FF2_OFF / 2; j.K = 8192; j.N = 2048; j.kt = r % 128; j.nt = r / 128; }
    return j;
}
__device__ __forceinline__ void phase_prologue(const Params& p, LAS unsigned char* lds) {
    const int tid = opaque_tid(), G = gridDim.x, bid = blockIdx.x;
    unsigned char* ws = p.ws;
    { float* rc = (float*)(ws + WS_ROPE); float* rs = rc + 2048 * 48;
      for (int i = bid * NTHREADS + tid; i < 2048 * 48; i += G * NTHREADS) { const int t = i / 48, a = i % 48; const int f = a % 24;
          const float inv = powf(10000.0f, -(float)f / 24.0f); const float pos = (a < 24) ? (float)(t / 64) : (float)(t % 64); const float ang = pos * inv;
          rc[i] = cosf(ang); rs[i] = sinf(ang); } }
    { LAS float* sl = (LAS float*)lds; LAS float* red = sl + 9 * 2048;
      bool loaded = false;
      for (int item = bid; item < 384; item += G) {
          if (!loaded) { for (int i = tid; i < 9 * 2048; i += NTHREADS) { const float v = (i < 8 * 2048) ? p.in[I_C][i] : p.in[I_CCTX][i - 8 * 2048]; sl[i] = siluf(v); } loaded = true; __syncthreads(); }
          const int l = item / 192, n0 = (item % 192) * 64; const int kq = tid >> 6, col = tid & 63;
          const float* W = p.in[I_WMOD] + (size_t)l * 2048 * 12288 + n0 + col;
          float acc[9];
#pragma unroll
          for (int r = 0; r < 9; ++r) acc[r] = 0.f;
          for (int k0 = kq * 256; k0 < kq * 256 + 256; k0 += 16) { float w[16];
#pragma unroll
              for (int i = 0; i < 16; ++i) w[i] = W[(size_t)(k0 + i) * 12288];
#pragma unroll
              for (int i4 = 0; i4 < 4; ++i4)
#pragma unroll
                  for (int r = 0; r < 9; ++r) { const f32x4 s = *(const LAS f32x4*)(sl + r * 2048 + k0 + i4 * 4); acc[r] += s[0] * w[i4 * 4] + s[1] * w[i4 * 4 + 1] + s[2] * w[i4 * 4 + 2] + s[3] * w[i4 * 4 + 3]; } }
#pragma unroll
          for (int r = 0; r < 9; ++r) red[(kq * 9 + r) * 64 + col] = acc[r];
          __syncthreads();
          for (int idx = tid; idx < 576; idx += NTHREADS) { const int r = idx >> 6, cc = idx & 63; float s = 0.f;
#pragma unroll
              for (int q = 0; q < 8; ++q) s += red[(q * 9 + r) * 64 + cc];
              ((float*)(ws + WS_MOD))[((size_t)l * 9 + r) * 12288 + n0 + cc] = s + p.in[I_BMOD][l * 12288 + n0 + cc]; }
          __syncthreads();
      }
      __syncthreads();
    }
    { LAS float* z = (LAS float*)lds; LAS float* h1 = z + 8 * 36;
      for (int item = bid; item < 544; item += G) {
          int l, Ls, i0; float* HD;
          if (item < 512) { l = item >> 8; Ls = SEQ; i0 = (item & 255) * 8; HD = (float*)(ws + WS_HD) + (size_t)l * 2048 * 64; }
          else { l = 0; Ls = LC; i0 = (item - 512) * 8; HD = (float*)(ws + WS_HD) + (size_t)2 * 2048 * 64; }
          if (tid < 264) { const int pos = tid / 33, e = tid % 33; const int i = i0 + pos;
              const float t = (float)i / (float)(Ls - 1); const float w = (6.283185307179586f / (float)Ls) * (float)i; float v;
              if (e == 0) v = t; else { const int k = (e - 1) & 15; const float band = 1e-4f + (float)k * ((15.0f - 1e-4f) / 15.0f); const float a = band * w; v = (e <= 16) ? cosf(a) : -sinf(a); }
              z[pos * 36 + e] = v; }
          __syncthreads();
          const int pos = tid >> 6, j = tid & 63;
          { float s = p.in[I_HB1][l * 64 + j]; const float* w1 = p.in[I_HW1] + (size_t)l * 33 * 64 + j;
            for (int e = 0; e < 33; ++e) s += z[pos * 36 + e] * w1[e * 64];
            h1[pos * 64 + j] = sinf(p.in[I_HFREQ][l * 64 + j] * s); }
          __syncthreads();
          { float s = p.in[I_HB2][l * 64 + j]; const float* w2 = p.in[I_HW2] + (size_t)l * 64 * 64 + j;
            for (int e = 0; e < 64; ++e) s += h1[pos * 64 + e] * w2[e * 64];
            HD[(size_t)(i0 + pos) * 64 + j] = sinf(p.in[I_HFREQ][l * 64 + j] * s); }
          __syncthreads();
      }
    }
    { LAS float* tile = (LAS float*)lds;
      constexpr int T_ALL = 2 * (32 * 112 + 32 * 32 + 32 * 128 + 128 * 32);
      for (int it0 = bid * 4; it0 < T_ALL; it0 += G * 4) {
          float4 v[4][2];
#pragma unroll
          for (int q = 0; q < 4; ++q) { const WtJob j = wt_job(p, it0 + q); const int k0 = j.kt * 64, n0 = j.nt * 64;
#pragma unroll
              for (int pp = 0; pp < 2; ++pp) { const int kk = (tid >> 4) + pp * 32, n4 = (tid & 15) * 4;
                  v[q][pp] = make_float4(0.f, 0.f, 0.f, 0.f);
                  if (n0 + n4 < j.N) v[q][pp] = *(const float4*)(j.W + (size_t)(k0 + kk) * j.N + n0 + n4); } }
#pragma unroll
          for (int q = 0; q < 4; ++q)
#pragma unroll
              for (int pp = 0; pp < 2; ++pp) { const int kk = (tid >> 4) + pp * 32, n4 = (tid & 15) * 4; LAS float* t = tile + q * 64 * 65;
                  t[(n4 + 0) * 65 + kk] = v[q][pp].x; t[(n4 + 1) * 65 + kk] = v[q][pp].y; t[(n4 + 2) * 65 + kk] = v[q][pp].z; t[(n4 + 3) * 65 + kk] = v[q][pp].w; }
          __syncthreads();
#pragma unroll
          for (int q = 0; q < 4; ++q) { const WtJob j = wt_job(p, it0 + q); const int k0 = j.kt * 64, n0 = j.nt * 64; const int nn = tid >> 3, k8 = (tid & 7) * 8; float f[8];
#pragma unroll
              for (int i = 0; i < 8; ++i) f[i] = tile[q * 64 * 65 + nn * 65 + k8 + i];
              *(u32x4*)(j.WT + (size_t)(n0 + nn) * j.K + k0 + k8) = pack8(f); }
          __syncthreads();
      }
    }
}

__device__ __forceinline__ void filter_items(const Params& p, LAS unsigned char* lds, int item0, int stride) {
    const int tid = opaque_tid(); unsigned char* ws = p.ws;
    LAS float* hd = (LAS float*)lds;
    LAS float* red = hd + 256 * 64;
    for (int item = item0; item < 136; item += stride) {
        int l, cg, isl, Ls; const float* HD; float* FX; float* NP;
        if (item < 128) { l = item >> 6; cg = (item >> 3) & 7; isl = item & 7; Ls = SEQ; HD = (const float*)(ws + WS_HD) + (size_t)l * 2048 * 64; FX = (float*)(ws + WS_FX) + (size_t)l * 4096 * 512;
            NP = (float*)(ws + WS_NORM) + (size_t)(l * 8 + isl) * 512; }
        else { l = 0; cg = item - 128; isl = 0; Ls = LC; HD = (const float*)(ws + WS_HD) + (size_t)2 * 2048 * 64; FX = (float*)(ws + WS_FC); NP = (float*)(ws + WS_NORM) + (size_t)16 * 512; }
        const int i0 = isl * 256;
        __syncthreads();
        for (int i = tid; i < 256 * 64; i += NTHREADS) hd[i] = HD[(size_t)i0 * 64 + i];
        __syncthreads();
        const int c = tid & 63, dir = (tid >> 6) & 1, sub = tid >> 7; const int ch = cg * 64 + c;
        float w3[64];
        { const float* w3p = p.in[I_HW3] + (size_t)l * 64 * 1024 + dir * 512 + ch;
#pragma unroll
          for (int j = 0; j < 64; ++j) w3[j] = w3p[j * 1024]; }
        const float lo = -4.605170185988091f / 1.5f, hi = -4.605170185988091f / 0.3f;
        const float delta = fabsf(lo + (float)ch * ((hi - lo) / 511.0f));
        float asum = 0.f;
        for (int ii = 0; ii < 64; ++ii) { const int li = sub * 64 + ii; const int pos = i0 + li;
            float dot = 0.f;
#pragma unroll
            for (int j4 = 0; j4 < 16; ++j4) { const f32x4 h = *(const LAS f32x4*)(hd + li * 64 + j4 * 4);
                dot += h[0] * w3[j4 * 4] + h[1] * w3[j4 * 4 + 1] + h[2] * w3[j4 * 4 + 2] + h[3] * w3[j4 * 4 + 3]; }
            const float t = (float)pos / (float)(Ls - 1);
            const float val = dot * __expf(-t * delta);
            if (!(dir == 1 && pos == 0)) { const int lag = dir ? -pos : pos; FX[(size_t)(lag + Ls - 1) * 512 + ch] = val; asum += fabsf(val); } }
        red[(tid >> 6) * 64 + c] = asum;
        __syncthreads();
        if (tid < 64) { float s = 0.f;
#pragma unroll
            for (int q = 0; q < 8; ++q) s += red[q * 64 + tid];
            NP[cg * 64 + tid] = s; }
    }
    __syncthreads();
}

__device__ __forceinline__ void phase_norm_mod(const float* __restrict__ xl, const float* __restrict__ xc, const float* __restrict__ g, const float* __restrict__ mod, int slot_shift, int nrows, bf16_t* __restrict__ act) {
    const int tidq = opaque_tid(); const int lane = tidq & 63; const int nw = gridDim.x * 8;
    const int vbq = (gridDim.x % 8 == 0) ? (blockIdx.x & 7) * (gridDim.x >> 3) + (blockIdx.x >> 3) : blockIdx.x; const int gw = vbq * 8 + (tidq >> 6);
    const int per = (nrows + nw - 1) / nw; const int r0 = gw * per; const int r1 = (r0 + per < nrows) ? r0 + per : nrows;
    int curb = -1; f32x4 fa[8], fb[8];
    for (int row = r0; row < r1; row += 2) {
        const bool two = row + 1 < r1; const int rowb = two ? row + 1 : row;
        const float* s0 = (row < ML_ROWS) ? xl + (size_t)row * D : xc + (size_t)(row - ML_ROWS) * D;
        const float* s1 = (rowb < ML_ROWS) ? xl + (size_t)rowb * D : xc + (size_t)(rowb - ML_ROWS) * D;
        f32x4 v0[8], v1[8]; float ss0 = 0.f, ss1 = 0.f;
#pragma unroll
        for (int i = 0; i < 8; ++i) { v0[i] = *(const f32x4*)(s0 + i * 256 + lane * 4); v1[i] = *(const f32x4*)(s1 + i * 256 + lane * 4); }
#pragma unroll
        for (int i = 0; i < 8; ++i) { ss0 += v0[i][0] * v0[i][0] + v0[i][1] * v0[i][1] + v0[i][2] * v0[i][2] + v0[i][3] * v0[i][3]; ss1 += v1[i][0] * v1[i][0] + v1[i][1] * v1[i][1] + v1[i][2] * v1[i][2] + v1[i][3] * v1[i][3]; }
        ss0 = wave_sum(ss0); ss1 = wave_sum(ss1);
#pragma unroll
        for (int h = 0; h < 2; ++h) { if (h == 1 && !two) break;
            const int rr = h ? rowb : row; const int b = (rr < ML_ROWS) ? (rr >> 11) : 8;
            if (b != curb) { curb = b; const float* sh = mod + (size_t)b * 12288 + slot_shift * 2048; const float* sc = sh + 2048;
#pragma unroll
                for (int i = 0; i < 8; ++i) { const int c = i * 256 + lane * 4; const f32x4 gg = *(const f32x4*)(g + c), s1v = *(const f32x4*)(sc + c); fb[i] = *(const f32x4*)(sh + c); fa[i] = gg * (s1v + 1.0f); } }
            const float r = rsqrtf((h ? ss1 : ss0) * (1.0f / D) + EPS);
#pragma unroll
            for (int i = 0; i < 8; ++i) { const int c = i * 256 + lane * 4; const f32x4 x = h ? v1[i] : v0[i]; const f32x4 o = (x * r) * fa[i] + fb[i];
                u32x2 w; w.x = cvt_pk_bf16(o[0], o[1]); w.y = cvt_pk_bf16(o[2], o[3]);
                *(u32x2*)(act + (size_t)rr * D + c) = w; } }
    }
}

__device__ __forceinline__ void phase_qk(const Params& p, int l) {
    const int tidq = opaque_tid(); unsigned char* ws = p.ws;
    const bf16_t* P = (const bf16_t*)(ws + WS_PH); bf16_t* QK = (bf16_t*)(ws + WS_ACT) + 512;
    const float* cw = p.in[I_MLCW] + (size_t)l * 3 * 1536;
    const int nunits = (MT_ROWS / 4) * 192;
    for (int u = blockIdx.x * NTHREADS + tidq; u < nunits; u += gridDim.x * NTHREADS) { const int cg = u % 192, r0 = (u / 192) * 4; const int c0 = cg * 8;
        const int seg_lo = (r0 < ML_ROWS) ? (r0 & ~2047) : (ML_ROWS + ((r0 - ML_ROWS) & ~255)); const int seg_hi = seg_lo + ((r0 < ML_ROWS) ? SEQ : LC);
        u32x4 raw[6];
#pragma unroll
        for (int t = 0; t < 6; ++t) { const int row = r0 - 1 + t; raw[t] = (row >= seg_lo && row < seg_hi) ? *(const u32x4*)(P + (size_t)row * NINP + C_MLQ + c0) : (u32x4){0u, 0u, 0u, 0u}; }
        float w0[8], w1[8], w2[8];
#pragma unroll
        for (int i = 0; i < 8; ++i) { w0[i] = cw[c0 + i]; w1[i] = cw[1536 + c0 + i]; w2[i] = cw[3072 + c0 + i]; }
        const float sc = (c0 >= 768) ? 0.07216878364870322f : 1.0f;
#pragma unroll
        for (int rr = 0; rr < 4; ++rr) { float xa[8], xb[8], xc[8], o[8]; unpack8(raw[rr], xa); unpack8(raw[rr + 1], xb); unpack8(raw[rr + 2], xc);
#pragma unroll
            for (int i = 0; i < 8; ++i) { const float v = w0[i] * xa[i] + w1[i] * xb[i] + w2[i] * xc[i]; o[i] = siluf(v) * sc; }
            *(u32x4*)(QK + (size_t)(r0 + rr) * D + c0) = pack8(o); } }
}

__device__ __forceinline__ f32x4 mfma16(const bf16x8 a, const bf16x8 b, const f32x4 c) { return __builtin_amdgcn_mfma_f32_16x16x32_bf16(a, b, c, 0, 0, 0); }

template <int DK, int NT, bool IS_ML>
__device__ __forceinline__ void scan_chain(const Params& p, int l, int item, LAS unsigned char* lds) {
    constexpr int LDQ = DK + 8, LDS2 = 136, LDC = DK + 8, KS = DK / 32, DPG = IS_ML ? 6 : 3, CG8 = DK / 8;
    constexpr int R0B = (128 * LDQ * 2 > 128 * LDS2 * 2) ? 128 * LDQ * 2 : 128 * LDS2 * 2;
    constexpr int R1B = (128 * LDQ * 2 > DK * LDS2 * 2) ? 128 * LDQ * 2 : DK * LDS2 * 2;
    constexpr int R2B = NT * 16 * LDS2 * 2, R3B = NT * 16 * LDC * 2;
    constexpr int NKR = (128 * CG8 + NTHREADS - 1) / NTHREADS;
    LAS bf16_t* Qs = (LAS bf16_t*)lds;
    LAS bf16_t* Ks = (LAS bf16_t*)(lds + R0B);
    LAS bf16_t* Vt = (LAS bf16_t*)(lds + R0B + R1B);
    LAS bf16_t* Ct = (LAS bf16_t*)(lds + R0B + R1B + R2B);
    LAS float* vec = (LAS float*)(lds + R0B + R1B + R2B + R3B);
    LAS float* colterm = vec; LAS float* rowterm = vec + 128; LAS float* winter = vec + 256; LAS float* wkv = vec + 384; LAS float* oscale = vec + 512; LAS float* scal = vec + 640;
    static_assert(R0B + R1B + R2B + R3B + 656 * 4 <= LDS_BYTES - 64, "LDS");

    int tid_ = threadIdx.x; asm volatile("" : "+v"(tid_));
    const int tid = tid_, wid = __builtin_amdgcn_readfirstlane(tid >> 6), lane = tid & 63, fr = lane & 15, fq = lane >> 4;
    const int sl = item & 3, dir = (item >> 2) & 1, h = (item >> 3) & 3, b = item >> 5;
    unsigned char* ws = p.ws;
    const bf16_t* P = (const bf16_t*)(ws + WS_PH);
    bf16_t* OUT = (bf16_t*)(ws + (IS_ML ? WS_OM : WS_OR) + (size_t)dir * OMR_DIR);
    const float* GATE = (const float*)(ws + WS_GATE);
    const float* ropec = (const float*)(ws + WS_ROPE); const float* ropes = ropec + 2048 * 48;

    __syncthreads();
    for (int i = tid; i < NT * 16 * LDC / 2; i += NTHREADS) ((LAS unsigned*)Ct)[i] = 0u;
    if (IS_ML) { for (int u = tid; u < 16 * 128; u += NTHREADS) { const int e = 48 + (u >> 7), j = u & 127; Vt[e * LDS2 + j] = (e == 48) ? (bf16_t)0x3F80 : (bf16_t)0; } }
    if (!IS_ML) { const float lg = -__expf(p.in[I_RTLD][l * 8 + dir * 4 + h]);
        if (tid < 128) { const float j = (float)tid; colterm[tid] = __expf(-lg * j); rowterm[tid] = __expf(lg * j); winter[tid] = __expf(lg * (j + 1.0f)); wkv[tid] = __expf(lg * (127.0f - j)); oscale[tid] = 0.f; }
        if (tid == 0) { scal[0] = __expf(lg * 128.0f); scal[1] = 0.f; } }
    if (IS_ML && tid == 0) { float one = 1.0f, zero = 0.f; asm volatile("" : "+v"(one), "+v"(zero)); scal[0] = one; scal[1] = zero; }
    f32x4 accC[DPG];
#pragma unroll
    for (int i = 0; i < DPG; ++i) accC[i] = (f32x4){0.f, 0.f, 0.f, 0.f};
    float gbi = 0.f, gbf = 0.f;
    if (IS_ML) { gbi = p.in[I_MLGB][l * 16 + dir * 8 + h]; gbf = p.in[I_MLGB][l * 16 + dir * 8 + 4 + h]; }
    __syncthreads();

    const int tid_chain = tid;
    for (int step = 0; step < 18; ++step) {
        int tq_ = tid_chain; asm volatile("" : "+v"(tq_));
        const int tid = tq_, wid = __builtin_amdgcn_readfirstlane(tid >> 6), lane = tid & 63, fr = lane & 15, fq = lane >> 4;
        const bool isctx = step < 2; const int nch = isctx ? 2 : 16; const int ci = isctx ? step : step - 2; const int chunk = dir ? (nch - 1 - ci) : ci;
        const int seg_lo = isctx ? (ML_ROWS + b * LC) : b * SEQ; const int seg_hi = seg_lo + (isctx ? LC : SEQ);
        const int rowbase = seg_lo + chunk * 128;
        u32x4 vreg[2]; float g_i = 0.f, g_f = 0.f;
        { const int vc = (IS_ML ? C_MLV : C_RV) + h * 192 + sl * 48;
#pragma unroll
          for (int k = 0; k < 2; ++k) { const int u = tid + k * NTHREADS; vreg[k] = (u32x4){0u, 0u, 0u, 0u};
              if (u < 128 * 6) { const int j = u & 127, e0 = (u >> 7) * 8; const int row = dir ? rowbase + 127 - j : rowbase + j; vreg[k] = *(const u32x4*)(P + (size_t)row * NINP + vc + e0); } }
          if (IS_ML && tid < 128) { const int row = dir ? rowbase + 127 - tid : rowbase + tid; g_i = GATE[(size_t)row * 16 + dir * 8 + h]; g_f = GATE[(size_t)row * 16 + dir * 8 + 4 + h]; } }
        if (IS_ML) {
            { const bf16_t* QK = (const bf16_t*)(ws + WS_ACT) + 512 + h * 192; u32x4 raw[12];
#pragma unroll
              for (int k = 0; k < 12; ++k) { const int u = tid + k * NTHREADS; const int cgq = u % 48, rch = u / 48; raw[k] = *(const u32x4*)(QK + (size_t)(rowbase + rch) * D + ((cgq >= 24) ? 768 : 0) + (cgq % 24) * 8); }
#pragma unroll
              for (int k = 0; k < 12; ++k) { const int u = tid + k * NTHREADS; const int cgq = u % 48, rch = u / 48; const int j = dir ? 127 - rch : rch;
                  *(LAS u32x4*)(((cgq >= 24) ? Ks : Qs) + j * LDQ + (cgq % 24) * 8) = raw[k]; } }
        } else {
            for (int u = tid; u < 128 * 6; u += NTHREADS) { const int j = u / 6, d0 = (u % 6) * 8; const int row = dir ? rowbase + 127 - j : rowbase + j;
                float cs[8], sn[8];
                if (!isctx) { const int t = row - seg_lo;
#pragma unroll
                    for (int i = 0; i < 8; ++i) { cs[i] = ropec[t * 48 + d0 + i]; sn[i] = ropes[t * 48 + d0 + i]; } }
                else {
#pragma unroll
                    for (int i = 0; i < 8; ++i) { cs[i] = 1.f; sn[i] = 0.f; } }
#pragma unroll
                for (int qk = 0; qk < 2; ++qk) { const int pc = (qk ? C_RK : C_RQ) + h * 96 + d0; const bf16_t* pr = P + (size_t)row * NINP + pc;
                    float a1[8], a2[8], o1[8], o2[8]; unpack8(*(const u32x4*)pr, a1); unpack8(*(const u32x4*)(pr + 48), a2);
                    const float sc = qk ? 1.0f : 0.10206207261596575f;
#pragma unroll
                    for (int i = 0; i < 8; ++i) { o1[i] = (a1[i] * cs[i] - a2[i] * sn[i]) * sc; o2[i] = (a1[i] * sn[i] + a2[i] * cs[i]) * sc; }
                    LAS bf16_t* dst = (qk ? Ks : Qs) + j * LDQ + d0;
                    *(LAS u32x4*)dst = pack8(o1); *(LAS u32x4*)(dst + 48) = pack8(o2); } }
        }
#pragma unroll
        for (int k = 0; k < 2; ++k) { const int u = tid + k * NTHREADS; if (u < 128 * 6) { const int j = u & 127, e0 = (u >> 7) * 8; const u32x4 v = vreg[k];
              Vt[(e0 + 0) * LDS2 + j] = (bf16_t)(v.x & 0xFFFFu); Vt[(e0 + 1) * LDS2 + j] = (bf16_t)(v.x >> 16);
              Vt[(e0 + 2) * LDS2 + j] = (bf16_t)(v.y & 0xFFFFu); Vt[(e0 + 3) * LDS2 + j] = (bf16_t)(v.y >> 16);
              Vt[(e0 + 4) * LDS2 + j] = (bf16_t)(v.z & 0xFFFFu); Vt[(e0 + 5) * LDS2 + j] = (bf16_t)(v.z >> 16);
              Vt[(e0 + 6) * LDS2 + j] = (bf16_t)(v.w & 0xFFFFu); Vt[(e0 + 7) * LDS2 + j] = (bf16_t)(v.w >> 16); } }
        if (IS_ML) { if (tid < 128) { colterm[tid] = g_i + gbi; const float gf = g_f + gbf; rowterm[tid] = fminf(gf, 0.f) - log1pf(__expf(-fabsf(gf))); } }
        __syncthreads();
        if (IS_ML) {
            if (wid == 0) {
                const float mprev = scal[1];
                const int j0 = 2 * lane, j1 = j0 + 1;
                const float i0 = colterm[j0], i1 = colterm[j1], f0 = rowterm[j0], f1 = rowterm[j1];
                float s = f0 + f1;
#pragma unroll
                for (int o = 1; o < 64; o <<= 1) { const float t = __shfl_up(s, o); if (lane >= o) s += t; }
                const float excl = s - (f0 + f1);
                const float b0 = excl + f0, b1 = excl + f0 + f1;
                const float a0 = i0 - b0, a1 = i1 - b1;
                float mx = fmaxf(a0, a1);
#pragma unroll
                for (int o = 1; o < 64; o <<= 1) { const float t = __shfl_up(mx, o); if (lane >= o) mx = fmaxf(mx, t); }
                float exm = __shfl_up(mx, 1); if (lane == 0) exm = -3.0e38f;
                const float M0 = fmaxf(fmaxf(mprev, exm), a0), M1 = fmaxf(M0, a1);
                const float Mlast = __shfl(M1, 63); const float bend = __shfl(b1, 63);
                colterm[j0] = a0; colterm[j1] = a1; rowterm[j0] = M0; rowterm[j1] = M1;
                winter[j0] = __expf(mprev - M0); winter[j1] = __expf(mprev - M1);
                wkv[j0] = __expf(a0 - Mlast); wkv[j1] = __expf(a1 - Mlast);
                oscale[j0] = __expf(-(b0 + M0)); oscale[j1] = __expf(-(b1 + M1));
                if (lane == 0) { scal[0] = __expf(mprev - Mlast); scal[1] = bend + Mlast; }
            }
            __syncthreads();
        }
        const float decay = scal[0];
        const int tt = (wid < 4) ? wid : 11 - wid;
        const int trow = 16 * tt + fr;
        bf16x8 qf[KS];
#pragma unroll
        for (int ks = 0; ks < KS; ++ks) qf[ks] = *(const LAS bf16x8*)(Qs + trow * LDQ + ks * 32 + fq * 8);
        f32x4 accO[NT];
        { bf16x8 cf[2][KS];
#pragma unroll
          for (int ks = 0; ks < KS; ++ks) cf[0][ks] = *(const LAS bf16x8*)(Ct + fr * LDC + ks * 32 + fq * 8);
#pragma unroll
          for (int nt = 0; nt < NT; ++nt) { accO[nt] = (f32x4){0.f, 0.f, 0.f, 0.f};
              if (nt + 1 < NT) {
#pragma unroll
                  for (int ks = 0; ks < KS; ++ks) cf[(nt + 1) & 1][ks] = *(const LAS bf16x8*)(Ct + (16 * (nt + 1) + fr) * LDC + ks * 32 + fq * 8); }
#pragma unroll
              for (int ks = 0; ks < KS; ++ks) accO[nt] = mfma16(cf[nt & 1][ks], qf[ks], accO[nt]); } }
        { const float wi = winter[trow];
#pragma unroll
          for (int nt = 0; nt < NT; ++nt) accO[nt] *= wi; }
        f32x4 accS[8];
        { bf16x8 kf[2][KS];
#pragma unroll
          for (int ks = 0; ks < KS; ++ks) kf[0][ks] = *(const LAS bf16x8*)(Ks + fr * LDQ + ks * 32 + fq * 8);
#pragma unroll
          for (int ns = 0; ns < 8; ++ns) { accS[ns] = (f32x4){0.f, 0.f, 0.f, 0.f};
              if (ns <= tt) {
                  if (ns + 1 <= tt && ns + 1 < 8) {
#pragma unroll
                      for (int ks = 0; ks < KS; ++ks) kf[(ns + 1) & 1][ks] = *(const LAS bf16x8*)(Ks + (16 * (ns + 1) + fr) * LDQ + ks * 32 + fq * 8); }
#pragma unroll
                  for (int ks = 0; ks < KS; ++ks) accS[ns] = mfma16(kf[ns & 1][ks], qf[ks], accS[ns]); } } }
        u32x4 kreg[NKR];
#pragma unroll
        for (int q = 0; q < NKR; ++q) { const int u = tid + q * NTHREADS; if (u < 128 * CG8) { const int j = u & 127, d0 = (u >> 7) * 8; kreg[q] = *(const LAS u32x4*)(Ks + j * LDQ + d0); } else kreg[q] = (u32x4){0u, 0u, 0u, 0u}; }
        __syncthreads();
        { const float rt = rowterm[trow];
#pragma unroll
          for (int ns = 0; ns < 8; ++ns) { u32x2 w = (u32x2){0u, 0u};
              if (ns <= tt) { float v[4]; const f32x4 ct = *(const LAS f32x4*)(colterm + 16 * ns + fq * 4);
#pragma unroll
                  for (int jj = 0; jj < 4; ++jj) { const int s = 16 * ns + fq * 4 + jj; const float e = (IS_ML ? __expf(fminf(ct[jj] - rt, 0.f)) : ct[jj] * rt) * ((s <= trow) ? 1.0f : 0.0f); v[jj] = accS[ns][jj] * e; }
                  w.x = cvt_pk_bf16(v[0], v[1]); w.y = cvt_pk_bf16(v[2], v[3]); }
              *(LAS u32x2*)(Qs + trow * LDS2 + 16 * ns + fq * 4) = w; } }
#pragma unroll
        for (int q = 0; q < NKR; ++q) { const int u = tid + q * NTHREADS; if (u < 128 * CG8) { const int j = u & 127, d0 = (u >> 7) * 8; float f[8]; unpack8(kreg[q], f); const float wk = wkv[j];
#pragma unroll
                for (int i = 0; i < 8; ++i) Ks[(d0 + i) * LDS2 + j] = f2bf(f[i] * wk); } }
        __syncthreads();
#pragma unroll
        for (int ks = 0; ks < 4; ++ks) { if (ks * 2 <= tt) { const bf16x8 sf = *(const LAS bf16x8*)(Qs + trow * LDS2 + ks * 32 + fq * 8);
#pragma unroll
                for (int nt = 0; nt < NT; ++nt) { const bf16x8 vf = *(const LAS bf16x8*)(Vt + (16 * nt + fr) * LDS2 + ks * 32 + fq * 8); accO[nt] = mfma16(vf, sf, accO[nt]); } } }
        { float inv = 1.0f;
          if (IS_ML) { const float den = __shfl(accO[NT - 1][0], fr); inv = 1.0f / fmaxf(fabsf(den), oscale[trow]); }
          const int row = dir ? rowbase + 127 - trow : rowbase + trow;
          bf16_t* op = OUT + ((size_t)(h * 4 + sl) * MT_ROWS + row) * 48 + fq * 4;
#pragma unroll
          for (int nt = 0; nt < 3; ++nt) { u32x2 w; w.x = cvt_pk_bf16(accO[nt][0] * inv, accO[nt][1] * inv); w.y = cvt_pk_bf16(accO[nt][2] * inv, accO[nt][3] * inv); *(u32x2*)(op + nt * 16) = w; } }
        if (wid < 2 * NT) { const int et = wid % NT, grp = wid / NT;
            bf16x8 vf4[4];
#pragma unroll
            for (int ks = 0; ks < 4; ++ks) vf4[ks] = *(const LAS bf16x8*)(Vt + (16 * et + fr) * LDS2 + ks * 32 + fq * 8);
            bf16x8 kw[2][4];
#pragma unroll
            for (int ks = 0; ks < 4; ++ks) kw[0][ks] = *(const LAS bf16x8*)(Ks + (16 * (grp * DPG) + fr) * LDS2 + ks * 32 + fq * 8);
#pragma unroll
            for (int dt = 0; dt < DPG; ++dt) { const int dtile = grp * DPG + dt; accC[dt] *= decay;
                if (dt + 1 < DPG) {
#pragma unroll
                    for (int ks = 0; ks < 4; ++ks) kw[(dt + 1) & 1][ks] = *(const LAS bf16x8*)(Ks + (16 * (dtile + 1) + fr) * LDS2 + ks * 32 + fq * 8); }
#pragma unroll
                for (int ks = 0; ks < 4; ++ks) accC[dt] = mfma16(kw[dt & 1][ks], vf4[ks], accC[dt]);
                u32x2 w; w.x = cvt_pk_bf16(accC[dt][0], accC[dt][1]); w.y = cvt_pk_bf16(accC[dt][2], accC[dt][3]);
                *(LAS u32x2*)(Ct + (16 * et + fr) * LDC + 16 * dtile + fq * 4) = w; } }
        __syncthreads();
    }
}

template <int LS>
__device__ __forceinline__ void hyena_item(const Params& p, int l, int b, int cg, int tb, bool isctx, LAS unsigned char* lds) {
    const int tid_ = opaque_tid();
    const int lane = tid_ & 63, wid = __builtin_amdgcn_readfirstlane(tid_ >> 6); unsigned char* ws = p.ws;
    LAS float* zs = (LAS float*)lds;
    LAS float* fs = zs + 64 * 64;
    const int ch = cg * 64 + lane; const int seg_lo = isctx ? (ML_ROWS + b * LC) : b * SEQ;
    const bf16_t* Pb = (const bf16_t*)(ws + WS_PH) + (size_t)seg_lo * NINP + cg * 64;
    bf16_t* Yb = (bf16_t*)(ws + WS_ACT) + (size_t)seg_lo * D + cg * 64;
    const float* FX = (isctx ? (const float*)(ws + WS_FC) : (const float*)(ws + WS_FX) + (size_t)l * 4096 * 512) + cg * 64;
    const float* NP = isctx ? (const float*)(ws + WS_NORM) + 16 * 512 : (const float*)(ws + WS_NORM) + (size_t)l * 8 * 512;
    const float* cw = p.in[I_HYCW] + (size_t)l * 3 * 1536;
    const float wx0a = cw[C_X0 + ch], wx0b = cw[1536 + C_X0 + ch], wx0c = cw[3072 + C_X0 + ch];
    const float wx1a = cw[C_X1 + ch], wx1b = cw[1536 + C_X1 + ch], wx1c = cw[3072 + C_X1 + ch];
    const float wva = cw[C_HV + ch], wvb = cw[1536 + C_HV + ch], wvc = cw[3072 + C_HV + ch];
    const int tblk = tb * 256, t0 = tblk + wid * 32;
    float acc[32];
#pragma unroll
    for (int i = 0; i < 32; ++i) acc[i] = 0.f;
    for (int sc = 0; sc < LS; sc += 64) {
        __syncthreads();
        { const int s8 = sc + wid * 8; const bf16_t* ps = Pb + (size_t)s8 * NINP;
          float pv0 = (s8 > 0) ? bf2f(ps[-NINP + C_HV + lane]) : 0.f, px0 = (s8 > 0) ? bf2f(ps[-NINP + C_X1 + lane]) : 0.f;
          float pv1 = bf2f(ps[C_HV + lane]), px1 = bf2f(ps[C_X1 + lane]);
#pragma unroll
          for (int k = 0; k < 8; ++k) { float pv2 = 0.f, px2 = 0.f;
              if (s8 + k + 1 < LS) { pv2 = bf2f(ps[(k + 1) * NINP + C_HV + lane]); px2 = bf2f(ps[(k + 1) * NINP + C_X1 + lane]); }
              zs[(wid * 8 + k) * 64 + lane] = (wva * pv0 + wvb * pv1 + wvc * pv2) * (wx1a * px0 + wx1b * px1 + wx1c * px2);
              pv0 = pv1; pv1 = pv2; px0 = px1; px1 = px2; } }
        { const int jlo = tblk - sc - 63 + LS - 1;
#pragma unroll 8
          for (int r = wid; r < 319; r += 8) { const int j = jlo + r; fs[r * 64 + lane] = (j >= 0 && j <= 2 * LS - 2) ? FX[(size_t)j * 512 + lane] : 0.f; } }
        __syncthreads();
#pragma unroll 1
        for (int kb = 0; kb < 4; ++kb) {
            float z[16], f[47];
            const int rb = wid * 32 + 48 - kb * 16;
#pragma unroll
            for (int k = 0; k < 16; ++k) z[k] = zs[(kb * 16 + k) * 64 + lane];
#pragma unroll
            for (int i = 0; i < 47; ++i) f[i] = fs[(rb + i) * 64 + lane];
#pragma unroll
            for (int k = 0; k < 16; ++k) {
#pragma unroll
                for (int i = 0; i < 32; ++i) acc[i] += f[15 + i - k] * z[k]; }
        }
    }
    float nsum = 0.f;
    if (isctx) nsum = NP[ch]; else {
#pragma unroll
        for (int q = 0; q < 8; ++q) nsum += NP[q * 512 + ch]; }
    const float inv = 1.0f / nsum; const float bias = p.in[I_HBIAS][l * 512 + ch];
    { const bf16_t* pt = Pb + (size_t)t0 * NINP;
      float m0 = 0.f, m1 = 0.f, m2 = 0.f;
      if (t0 > 0) { m0 = bf2f(pt[-NINP + C_X0 + lane]); m1 = bf2f(pt[-NINP + C_X1 + lane]); m2 = bf2f(pt[-NINP + C_HV + lane]); }
      float a0 = bf2f(pt[C_X0 + lane]), a1 = bf2f(pt[C_X1 + lane]), a2 = bf2f(pt[C_HV + lane]);
#pragma unroll
      for (int i = 0; i < 32; ++i) { float q0 = 0.f, q1 = 0.f, q2 = 0.f;
          if (t0 + i + 1 < LS) { q0 = bf2f(pt[(i + 1) * NINP + C_X0 + lane]); q1 = bf2f(pt[(i + 1) * NINP + C_X1 + lane]); q2 = bf2f(pt[(i + 1) * NINP + C_HV + lane]); }
          const float x0 = wx0a * m0 + wx0b * a0 + wx0c * q0; const float x1 = wx1a * m1 + wx1b * a1 + wx1c * q1; const float vv = wva * m2 + wvb * a2 + wvc * q2;
          const float zt = vv * x1; const float y = (acc[i] * inv + bias * zt) * x0;
          Yb[(size_t)(t0 + i) * D + lane] = f2bf(y);
          m0 = a0; m1 = a1; m2 = a2; a0 = q0; a1 = q1; a2 = q2;
          if ((i & 7) == 7) asm volatile("" ::: "memory"); } }
}

__device__ __forceinline__ void hyena_mfma(const Params& p, int l, int item, LAS unsigned char* lds) {
    constexpr int ZLD = 2056, GLD = 4104;
    const int tid = opaque_tid(); const int lane = tid & 63, wid = __builtin_amdgcn_readfirstlane(tid >> 6), r = lane & 15, q = lane >> 4;
    unsigned char* ws = p.ws;
    LAS bf16_t* ZS = (LAS bf16_t*)lds;
    LAS bf16_t* GS = ZS + 2 * 8 * ZLD;
    const int c0 = item * 2;
    const bf16_t* P = (const bf16_t*)(ws + WS_PH); bf16_t* Y = (bf16_t*)(ws + WS_ACT);
    const float* FX = (const float*)(ws + WS_FX) + (size_t)l * 4096 * 512;
    const float* NP = (const float*)(ws + WS_NORM) + (size_t)l * 8 * 512;
    const float* cw = p.in[I_HYCW] + (size_t)l * 3 * 1536;
    __syncthreads();
    { const int b = tid >> 6, s0 = (tid & 63) * 32;
      float wv[2][3], wx[2][3];
#pragma unroll
      for (int c = 0; c < 2; ++c)
#pragma unroll
          for (int t = 0; t < 3; ++t) { wv[c][t] = cw[t * 1536 + C_HV + c0 + c]; wx[c][t] = cw[t * 1536 + C_X1 + c0 + c]; }
      const bf16_t* pb = P + (size_t)(b * SEQ) * NINP + c0;
      unsigned vr[34], xr_[34];
#pragma unroll
      for (int k = 0; k < 34; ++k) { const int s = s0 - 1 + k; const bool ok = (s >= 0) && (s < SEQ);
          vr[k] = ok ? *(const unsigned*)(pb + (size_t)s * NINP + C_HV) : 0u; xr_[k] = ok ? *(const unsigned*)(pb + (size_t)s * NINP + C_X1) : 0u; }
#pragma unroll
      for (int g = 0; g < 4; ++g) { float za[8], zb[8];
#pragma unroll
          for (int k = 0; k < 8; ++k) { const int i = g * 8 + k; const unsigned v0 = vr[i], v1 = vr[i + 1], v2 = vr[i + 2], x0 = xr_[i], x1 = xr_[i + 1], x2 = xr_[i + 2];
              za[k] = (wv[0][0] * bf_lo(v0) + wv[0][1] * bf_lo(v1) + wv[0][2] * bf_lo(v2)) * (wx[0][0] * bf_lo(x0) + wx[0][1] * bf_lo(x1) + wx[0][2] * bf_lo(x2));
              zb[k] = (wv[1][0] * bf_hi(v0) + wv[1][1] * bf_hi(v1) + wv[1][2] * bf_hi(v2)) * (wx[1][0] * bf_hi(x0) + wx[1][1] * bf_hi(x1) + wx[1][2] * bf_hi(x2)); }
          *(LAS u32x4*)(ZS + (0 * 8 + b) * ZLD + s0 + g * 8) = pack8(za);
          *(LAS u32x4*)(ZS + (1 * 8 + b) * ZLD + s0 + g * 8) = pack8(zb); } }
    f32x4 acc[16];
    const int t0 = wid * 256;
#pragma unroll 1
    for (int c = 0; c < 2; ++c) {
        const int ch = c0 + c;
        __syncthreads();
        { float nsum = 0.f;
#pragma unroll
          for (int qq = 0; qq < 8; ++qq) nsum += NP[qq * 512 + ch];
          const float inv = 1.0f / nsum; const float bias = p.in[I_HBIAS][l * 512 + ch];
#pragma unroll
          for (int i = 0; i < 8; ++i) { const int m = tid + i * 512; float g = 0.f;
              if (m <= 4094) { g = FX[(size_t)(4094 - m) * 512 + ch] * inv; if (m == 2047) g += bias; }
              const bf16_t gb = f2bf(g);
#pragma unroll
              for (int k = 0; k < 8; ++k) { if (m - k >= 0) GS[k * GLD + (m - k)] = gb; } }
        }
        __syncthreads();
        const int kc = (7 - r) & 7;
        const LAS bf16_t* gp = GS + kc * GLD + (2047 - t0 - r + 8 * q - kc);
        const LAS bf16_t* zp = ZS + (c * 8 + (lane & 7)) * ZLD + 8 * q;
        bf16x8 ring[16];
#pragma unroll
        for (int i = 0; i < 16; ++i) { acc[i] = (f32x4){0.f, 0.f, 0.f, 0.f}; ring[i] = *(const LAS bf16x8*)(gp - 16 * i); }
        bf16x8 zf = *(const LAS bf16x8*)zp;
#pragma unroll 1
        for (int J = 0; J < 8; ++J) {
#pragma unroll
            for (int jj = 0; jj < 8; ++jj) { const int j = J * 8 + jj;
                bf16x8 rn0 = zf, rn1 = zf, zn = zf;
                if (j + 1 < 64) { rn0 = *(const LAS bf16x8*)(gp + 16 * (2 * (j + 1))); rn1 = *(const LAS bf16x8*)(gp + 16 * (2 * (j + 1) - 1)); zn = *(const LAS bf16x8*)(zp + 32 * (j + 1)); }
#pragma unroll
                for (int i = 0; i < 16; ++i) acc[i] = mfma16(ring[(i - 2 * jj) & 15], zf, acc[i]);
                if (j + 1 < 64) { ring[(16 - 2 * (jj + 1)) & 15] = rn0; ring[(17 - 2 * (jj + 1)) & 15] = rn1; }
                zf = zn; } }
        __syncthreads();
        if (r < 8) { LAS bf16_t* yb_ = ZS + (c * 8 + r) * ZLD + t0 + 4 * q;
#pragma unroll
            for (int i = 0; i < 16; ++i) { u32x2 w; w.x = cvt_pk_bf16(acc[i][0], acc[i][1]); w.y = cvt_pk_bf16(acc[i][2], acc[i][3]); *(LAS u32x2*)(yb_ + 16 * i) = w; } }
    }
    __syncthreads();
    { const int b = tid >> 6;
      float w0[3], w1[3];
#pragma unroll
      for (int t = 0; t < 3; ++t) { w0[t] = cw[t * 1536 + C_X0 + c0]; w1[t] = cw[t * 1536 + C_X0 + c0 + 1]; }
      const bf16_t* pb = P + (size_t)(b * SEQ) * NINP + C_X0 + c0; bf16_t* yb = Y + (size_t)(b * SEQ) * D + c0;
      unsigned xall[8][6];
#pragma unroll
      for (int k = 0; k < 8; ++k) { const int tb = 4 * (tid & 63) + 256 * k;
#pragma unroll
          for (int u = 0; u < 6; ++u) { const int t = tb - 1 + u; xall[k][u] = (t >= 0 && t < SEQ) ? *(const unsigned*)(pb + (size_t)t * NINP) : 0u; } }
#pragma unroll
      for (int k = 0; k < 8; ++k) { const int tb = 4 * (tid & 63) + 256 * k;
          const unsigned* xr = xall[k];
          const u32x2 ya = *(const LAS u32x2*)(ZS + (0 * 8 + b) * ZLD + tb), yc = *(const LAS u32x2*)(ZS + (1 * 8 + b) * ZLD + tb);
          const float y0[4] = {bf_lo(ya.x), bf_hi(ya.x), bf_lo(ya.y), bf_hi(ya.y)}, y1[4] = {bf_lo(yc.x), bf_hi(yc.x), bf_lo(yc.y), bf_hi(yc.y)};
#pragma unroll
          for (int jj = 0; jj < 4; ++jj) {
              const float xa = w0[0] * bf_lo(xr[jj]) + w0[1] * bf_lo(xr[jj + 1]) + w0[2] * bf_lo(xr[jj + 2]);
              const float xb = w1[0] * bf_hi(xr[jj]) + w1[1] * bf_hi(xr[jj + 1]) + w1[2] * bf_hi(xr[jj + 2]);
              *(unsigned*)(yb + (size_t)(tb + jj) * D) = cvt_pk_bf16(y0[jj] * xa, y1[jj] * xb); } } }
    __syncthreads();
}

__device__ __forceinline__ void phase_mixers(const Params& p, int l, LAS unsigned char* lds) {
    const int G = gridDim.x, bid = blockIdx.x;
    const int vb = (G % 8 == 0) ? (bid & 7) * (G >> 3) + (bid >> 3) : bid;
    for (int item = vb; item < 256; item += G) scan_chain<192, 4, true>(p, l, item, lds);
    for (int item = vb; item < 256; item += G) scan_chain<96, 3, false>(p, l, item, lds);
    for (int item = vb; item < 256; item += G) hyena_mfma(p, l, item, lds);
    if (l == 0) { for (int item = G - 1 - bid; item < 64; item += G) hyena_item<LC>(p, l, item >> 3, item & 7, 0, true, lds); }
}

__device__ __forceinline__ void phase_combine(const Params& p, int l, int nrows) {
    const int tidq = opaque_tid(); unsigned char* ws = p.ws; const int lane = tidq & 63; const int gw = blockIdx.x * 8 + (tidq >> 6), nw = gridDim.x * 8;
    const bf16_t* P = (const bf16_t*)(ws + WS_PH); bf16_t* Y = (bf16_t*)(ws + WS_ACT);
    const float* ng = p.in[I_MLNG] + (size_t)l * 768;
    const int li = lane & 31, e0 = 6 * li, sl = li >> 3, ee = 6 * (li & 7);
    for (int u = gw; u < nrows * 4; u += nw) { const int row = u >> 2, grp = (u >> 1) & 1, h = (u & 1) * 2 + (lane >> 5);
        const bf16_t* o0 = (const bf16_t*)(ws + (grp ? WS_OR : WS_OM)) + ((size_t)(h * 4 + sl) * MT_ROWS + row) * 48 + ee; const bf16_t* o1 = o0 + OMR_DIR / 2;
        const bf16_t* gp = P + (size_t)row * NINP + (grp ? C_RG : C_MLO) + h * 192 + e0;
        unsigned a[3], c[3], gt[3];
#pragma unroll
        for (int i = 0; i < 3; ++i) { a[i] = ((const unsigned*)o0)[i]; c[i] = ((const unsigned*)o1)[i]; gt[i] = ((const unsigned*)gp)[i]; }
        float v[6]; float ss = 0.f;
#pragma unroll
        for (int i = 0; i < 3; ++i) { v[2 * i] = bf_lo(a[i]) + bf_lo(c[i]); v[2 * i + 1] = bf_hi(a[i]) + bf_hi(c[i]); ss += v[2 * i] * v[2 * i] + v[2 * i + 1] * v[2 * i + 1]; }
#pragma unroll
        for (int o = 16; o > 0; o >>= 1) ss += __shfl_xor(ss, o);
        const float r = rsqrtf(ss * (1.0f / 192.0f) + EPS);
        float y[6];
#pragma unroll
        for (int i = 0; i < 6; ++i) { const float g = (i & 1) ? bf_hi(gt[i >> 1]) : bf_lo(gt[i >> 1]);
            y[i] = grp ? (v[i] * r * siluf(g)) : (v[i] * r * ng[h * 192 + e0 + i] * sigmf(g)); }
        unsigned* yp = (unsigned*)(Y + (size_t)row * D + (grp ? 1280 : 512) + h * 192 + e0);
#pragma unroll
        for (int i = 0; i < 3; ++i) yp[i] = cvt_pk_bf16(y[2 * i], y[2 * i + 1]); }
}

__device__ __forceinline__ void phase_final(const Params& p) {
    const int tidq = opaque_tid(); const int lane = tidq & 63; const int gw = blockIdx.x * 8 + (tidq >> 6), nw = gridDim.x * 8;
    const float* g = p.in[I_FING];
    const int per = (ML_ROWS + nw - 1) / nw; const int r0 = gw * per; const int r1 = (r0 + per < ML_ROWS) ? r0 + per : ML_ROWS;
    f32x4 gg[8];
#pragma unroll
    for (int i = 0; i < 8; ++i) gg[i] = *(const f32x4*)(g + i * 256 + lane * 4);
    for (int row = r0; row < r1; row += 2) { const bool two = row + 1 < r1; float* s0 = p.out + (size_t)row * D; float* s1 = p.out + (size_t)(two ? row + 1 : row) * D;
        f32x4 v0[8], v1[8]; float ss0 = 0.f, ss1 = 0.f;
#pragma unroll
        for (int i = 0; i < 8; ++i) { v0[i] = *(const f32x4*)(s0 + i * 256 + lane * 4); v1[i] = *(const f32x4*)(s1 + i * 256 + lane * 4); }
#pragma unroll
        for (int i = 0; i < 8; ++i) { ss0 += v0[i][0] * v0[i][0] + v0[i][1] * v0[i][1] + v0[i][2] * v0[i][2] + v0[i][3] * v0[i][3]; ss1 += v1[i][0] * v1[i][0] + v1[i][1] * v1[i][1] + v1[i][2] * v1[i][2] + v1[i][3] * v1[i][3]; }
        ss0 = wave_sum(ss0); ss1 = wave_sum(ss1);
        const float ra = rsqrtf(ss0 * (1.0f / D) + EPS), rb = rsqrtf(ss1 * (1.0f / D) + EPS);
#pragma unroll
        for (int i = 0; i < 8; ++i) { const int c = i * 256 + lane * 4; *(f32x4*)(s0 + c) = v0[i] * ra * gg[i]; if (two) *(f32x4*)(s1 + c) = v1[i] * rb * gg[i]; } }
}

#define XB_TMO      128
#define XB_XCNT(j)  (256  + 64 * (j))
#define XB_XSUB(j)  (1280 + 64 * (j))
#define XB_XGEN(j)  (2304 + 64 * (j))
#define XB_TOP      3328
#define XB_TOPGEN   3392
#define XCD_BAR_WORDS 3456
#define XB_SPIN_CAP (1u << 22)
__device__ __forceinline__ unsigned xb_ld(unsigned* p)              { return __hip_atomic_load(p, __ATOMIC_RELAXED, __HIP_MEMORY_SCOPE_AGENT); }
__device__ __forceinline__ unsigned xb_add(unsigned* p, unsigned v) { return __hip_atomic_fetch_add(p, v, __ATOMIC_RELAXED, __HIP_MEMORY_SCOPE_AGENT); }
__device__ __forceinline__ unsigned xb_xcc_id() { return (unsigned)__builtin_amdgcn_s_getreg((3 << 11) | 20) & 0xFu; }
#define XB_SPIN(cond, bar) do { unsigned _sp = 0; while (cond) { __builtin_amdgcn_s_sleep(1); \
    if ((++_sp & 255u) == 0u) { if (xb_ld(&(bar)[XB_TMO])) break; if (_sp > XB_SPIN_CAP) { atomicAdd(&(bar)[XB_TMO], 1u); break; } } } } while (0)
struct XcdBarrier { unsigned* bar; volatile LAS unsigned* st; };
__device__ __forceinline__ XcdBarrier xcd_barrier_post(unsigned* bar, volatile LAS unsigned* st) {
    XcdBarrier b; b.bar = bar; b.st = st; const unsigned x = (unsigned)__builtin_amdgcn_readfirstlane((int)xb_xcc_id());
    if (threadIdx.x == 0) (void)xb_add(&bar[XB_XCNT(x)], 1u);
    return b;
}
__device__ __forceinline__ void xcd_barrier_complete(unsigned* bar, unsigned x, unsigned& nloc, unsigned& nx) {
    const unsigned G = gridDim.x * gridDim.y * gridDim.z;
    unsigned sum, cnt, mine, sp = 0u;
    for (;;) {
        sum = 0u; cnt = 0u; mine = 0u;
#pragma unroll
        for (unsigned j = 0; j < 16; ++j) { const unsigned c = xb_ld(&bar[XB_XCNT(j)]); sum += c; cnt += (c > 0u) ? 1u : 0u; mine = (j == x) ? c : mine; }
        if (sum == G) break;
        __builtin_amdgcn_s_sleep(1);
        if ((++sp & 255u) == 0u) { if (xb_ld(&bar[XB_TMO])) break; if (sp > XB_SPIN_CAP) { atomicAdd(&bar[XB_TMO], 1u); break; } }
    }
    nloc = mine > 0u ? mine : 1u; nx = cnt > 0u ? cnt : 1u;
}
__device__ __forceinline__ void xcd_barrier(const XcdBarrier& b) {
    asm volatile("s_waitcnt vmcnt(0)" ::: "memory");
    __syncthreads();
    if (threadIdx.x == 0) {
        unsigned* bar = b.bar; const unsigned bx = (unsigned)__builtin_amdgcn_readfirstlane((int)xb_xcc_id());
        __builtin_amdgcn_s_waitcnt(0);
        unsigned nloc = b.st[0], nx = b.st[1];
        if (nloc == 0u) { xcd_barrier_complete(bar, bx, nloc, nx); b.st[0] = nloc; b.st[1] = nx; }
        const unsigned old = xb_add(&bar[XB_XSUB(bx)], 1u);
        const unsigned gen = old / nloc;
        if (old + 1u == (gen + 1u) * nloc) {
            __builtin_amdgcn_fence(__ATOMIC_RELEASE, "agent");
            asm volatile("s_waitcnt vmcnt(0)" ::: "memory");
            const unsigned og = xb_add(&bar[XB_TOP], 1u);
            const unsigned tg = og / nx;
            if (og + 1u == (tg + 1u) * nx) xb_add(&bar[XB_TOPGEN], 1u);
            else XB_SPIN(xb_ld(&bar[XB_TOPGEN]) == tg, bar);
            __builtin_amdgcn_fence(__ATOMIC_ACQUIRE, "agent");
            xb_add(&bar[XB_XGEN(bx)], 1u);
            asm volatile("s_waitcnt vmcnt(0)" ::: "memory");
        } else {
            XB_SPIN(xb_ld(&bar[XB_XGEN(bx)]) == gen, bar);
            __builtin_amdgcn_fence(__ATOMIC_ACQUIRE, "agent");
            asm volatile("s_waitcnt vmcnt(0)" ::: "memory");
        }
    }
    __syncthreads();
}

#ifndef WGM_IN
#define WGM_IN 8
#define WGM_OUT 4
#define WGM_FF1 8
#define WGM_FF2 4
#endif
__global__ void __launch_bounds__(NTHREADS, 2) mk_fwd(Params p) {
    extern __shared__ __attribute__((aligned(16))) unsigned char lds_raw[];
    LAS unsigned char* lds = (LAS unsigned char*)lds_raw;
    cg::grid_group grid = cg::this_grid();
    unsigned char* ws = p.ws; const int G = gridDim.x, bid = blockIdx.x;
    bf16_t* ACT = (bf16_t*)(ws + WS_ACT); bf16_t* PH = (bf16_t*)(ws + WS_PH); float* XC = (float*)(ws + WS_XC);

    volatile LAS unsigned* bst = (volatile LAS unsigned*)(lds + LDS_BYTES - 32);
    if (threadIdx.x == 0) { bst[0] = 0u; bst[1] = 0u; }
    __syncthreads();
    const XcdBarrier xb = xcd_barrier_post((unsigned*)(ws + WS_BAR), bst);
    grid.sync();
    phase_prologue(p, lds);
    xcd_barrier(xb);
#pragma nounroll
    for (int l = 0; l < 2; ++l) {
        const float* mod = (const float*)(ws + WS_MOD) + (size_t)l * 9 * 12288;
        const bf16_t* wt = (const bf16_t*)(ws + WS_WT + (size_t)l * WT_LAYER);
        const float* xin = l == 0 ? p.in[I_X] : p.out; const float* cin = l == 0 ? p.in[I_CTX] : XC;
        if (l == 0) filter_items(p, lds, G - 1 - bid, G);
        phase_norm_mod(xin, cin, p.in[I_N1G] + l * D, mod, 0, MT_ROWS, ACT);
        xcd_barrier(xb);
        { pg8::StaticOrder S; S.init(MT_ROWS, NINP, G, bid, WGM_IN); EpiBf16<0> E{PH, NINP, (float*)(ws + WS_GATE)};
          pg8::gemm_phase(lds, pg8::Gemm{ACT, wt + WT_IN_OFF / 2, MT_ROWS, NINP, D}, S, E); }
        xcd_barrier(xb);
        phase_qk(p, l);
        xcd_barrier(xb);
        phase_mixers(p, l, lds);
        xcd_barrier(xb);
        phase_combine(p, l, l == 0 ? MT_ROWS : ML_ROWS);
        xcd_barrier(xb);
        const int Mr = l == 0 ? MT_ROWS : ML_ROWS;
        { pg8::StaticOrder S; S.init(Mr, D, G, bid, WGM_OUT); EpiRes E{xin, p.out, cin, XC, mod, 2};
          pg8::gemm_phase(lds, pg8::Gemm{ACT, wt + WT_OUT_OFF / 2, Mr, D, D}, S, E); }
        xcd_barrier(xb);
        phase_norm_mod(p.out, XC, p.in[I_N2G] + l * D, mod, 3, Mr, ACT);
        xcd_barrier(xb);
        { pg8::StaticOrder S; S.init(Mr, DFF, G, bid, WGM_FF1); EpiBf16<1> E{PH, DFF, nullptr};
          pg8::gemm_phase(lds, pg8::Gemm{ACT, wt + WT_FF1_OFF / 2, Mr, DFF, D}, S, E); }
        xcd_barrier(xb);
        { pg8::StaticOrder S; S.init(Mr, D, G, bid, WGM_FF2); EpiRes E{p.out, p.out, XC, XC, mod, 5};
          pg8::gemm_phase(lds, pg8::Gemm{PH, wt + WT_FF2_OFF / 2, Mr, D, DFF}, S, E); }
        xcd_barrier(xb);
    }
    phase_final(p);
}

extern "C" void kernel_launch(void* const* d_in, const int* in_sizes, int n_in, void* d_out, int out_size, void* d_ws, size_t ws_size, hipStream_t stream) {
    static int grid = 0;
    if (!grid) {
        int dev = 0, cus = 0, per_cu = 0;
        (void)hipGetDevice(&dev);
        (void)hipDeviceGetAttribute(&cus, hipDeviceAttributeMultiprocessorCount, dev);
        (void)hipFuncSetAttribute((const void*)mk_fwd, hipFuncAttributeMaxDynamicSharedMemorySize, LDS_BYTES);
        (void)hipOccupancyMaxActiveBlocksPerMultiprocessor(&per_cu, (const void*)mk_fwd, NTHREADS, LDS_BYTES);
        if (per_cu < 1) per_cu = 1;
        grid = cus * per_cu;
        if (ws_size < WS_END || n_in != 25) { fprintf(stderr, "kernel_launch: workspace %zu < %zu or n_in %d != 25\n", ws_size, (size_t)WS_END, n_in); }
    }
    (void)hipMemsetAsync((unsigned char*)d_ws + WS_BAR, 0, 16384, stream);
    Params p{};
    for (int i = 0; i < 25; ++i) p.in[i] = (const float*)d_in[i];
    p.out = (float*)d_out; p.ws = (unsigned char*)d_ws;
    void* args[] = {&p};
    hipError_t e = hipLaunchCooperativeKernel((const void*)mk_fwd, dim3(grid), dim3(NTHREADS), args, LDS_BYTES, stream);
    if (e != hipSuccess) fprintf(stderr, "cooperative launch failed: %s (grid %d)\n", hipGetErrorString(e), grid);
}
```

```cpp
#include <hip/hip_runtime.h>
#include <hip/hip_cooperative_groups.h>
#include <cstdio>
namespace cg = cooperative_groups;

#define LAS __attribute__((address_space(3)))
typedef unsigned short bf16_t;
typedef short bf16x8 __attribute__((ext_vector_type(8)));
typedef float f32x4 __attribute__((ext_vector_type(4)));
typedef unsigned u32x4 __attribute__((ext_vector_type(4)));
typedef unsigned u32x2 __attribute__((ext_vector_type(2)));

constexpr int D = 2048, NB = 8, SEQ = 2048, LC = 256;
constexpr int ML_ROWS = NB * SEQ;
constexpr int MC_ROWS = NB * LC;
constexpr int MT_ROWS = ML_ROWS + MC_ROWS;
constexpr int NIN = 6928, NINP = 7168, DFF = 8192;
constexpr int C_X0 = 0, C_X1 = 512, C_HV = 1024;
constexpr int C_MLQ = 1536, C_MLK = 2304, C_MLV = 3072, C_MLO = 3840, C_G = 4608;
constexpr int C_RQ = 4624, C_RK = 5008, C_RV = 5392, C_RG = 6160;
constexpr float EPS = 1e-6f;
constexpr int NTHREADS = 512;
constexpr int LDS_BYTES = 155648;

constexpr size_t WT_LAYER = 104857600ull;
constexpr size_t WT_IN_OFF = 0, WT_OUT_OFF = 29360128ull, WT_FF1_OFF = 37748736ull, WT_FF2_OFF = 71303168ull;
constexpr size_t WS_WT = 0;
constexpr size_t WS_ACT = 209715200ull;
constexpr size_t WS_PH = WS_ACT + 75497472ull;
constexpr size_t WS_XC = WS_PH + 301989888ull;
constexpr size_t WS_OM = WS_XC + 16777216ull;
constexpr size_t OMR_DIR = (size_t)MT_ROWS * 768 * 2;
constexpr size_t WS_OR = WS_OM + 2 * OMR_DIR;
constexpr size_t WS_FX = WS_OR + 2 * OMR_DIR;
constexpr size_t WS_FC = WS_FX + 16777216ull;
constexpr size_t WS_HD = WS_FC + 1048576ull;
constexpr size_t WS_MOD = WS_HD + 1114112ull;
constexpr size_t WS_GATE = WS_MOD + 884736ull;
constexpr size_t WS_ROPE = WS_GATE + 1179648ull;
constexpr size_t WS_NORM = WS_ROPE + 786432ull;
constexpr size_t WS_CTR = WS_NORM + 34816ull;
constexpr size_t WS_BAR = WS_CTR + 256ull;
constexpr size_t WS_END = WS_BAR + 16384ull;

struct Params { const float* in[25]; float* out; unsigned char* ws; };
enum { I_X = 0, I_C, I_CTX, I_CCTX, I_N1G, I_N2G, I_WMOD, I_BMOD, I_WIN, I_HYCW, I_HW1, I_HB1, I_HW2, I_HB2, I_HW3, I_HFREQ, I_HBIAS,
       I_MLCW, I_MLGB, I_MLNG, I_RTLD, I_WOUT, I_WFF1, I_WFF2, I_FING };

typedef float f32x2_t __attribute__((ext_vector_type(2)));
typedef __bf16 bf16x2_t __attribute__((ext_vector_type(2)));
__device__ __forceinline__ unsigned cvt_pk_bf16(float lo, float hi) { f32x2_t v = {lo, hi}; bf16x2_t b = __builtin_convertvector(v, bf16x2_t); return __builtin_bit_cast(unsigned, b); }
__device__ __forceinline__ float bf_lo(unsigned u) { return __uint_as_float(u << 16); }
__device__ __forceinline__ float bf_hi(unsigned u) { return __uint_as_float(u & 0xFFFF0000u); }
__device__ __forceinline__ float bf2f(bf16_t b) { return __uint_as_float(((unsigned)b) << 16); }
__device__ __forceinline__ bf16_t f2bf(float f) { return (bf16_t)(cvt_pk_bf16(f, 0.f) & 0xFFFFu); }
__device__ __forceinline__ float siluf(float x) { return x * __builtin_amdgcn_rcpf(1.0f + __expf(-x)); }
__device__ __forceinline__ float sigmf(float x) { return __builtin_amdgcn_rcpf(1.0f + __expf(-x)); }
__device__ __forceinline__ int opaque_tid() { int t = threadIdx.x; asm volatile("" : "+v"(t)); return t; }
__device__ __forceinline__ float wave_sum(float v) {
#pragma unroll
    for (int o = 32; o > 0; o >>= 1) v += __shfl_xor(v, o);
    return v;
}
__device__ __forceinline__ void unpack8(const u32x4 v, float (&f)[8]) {
    f[0] = bf_lo(v.x); f[1] = bf_hi(v.x); f[2] = bf_lo(v.y); f[3] = bf_hi(v.y); f[4] = bf_lo(v.z); f[5] = bf_hi(v.z); f[6] = bf_lo(v.w); f[7] = bf_hi(v.w);
}
__device__ __forceinline__ u32x4 pack8(const float (&f)[8]) {
    u32x4 w; w.x = cvt_pk_bf16(f[0], f[1]); w.y = cvt_pk_bf16(f[2], f[3]); w.z = cvt_pk_bf16(f[4], f[5]); w.w = cvt_pk_bf16(f[6], f[7]); return w;
}

namespace pg8 {
constexpr int BM = 256, BK = 64, HALF = 128, HTB = HALF * BK * 2, STAGE_BYTES = 8 * HTB, NXCD = 8, WGM = 4;
__host__ __device__ __forceinline__ int lds_byte(int r, int c) { const int st = (r >> 4) * 2 + (c >> 5), rr = r & 15, cc = c & 31, ob = rr * 64 + cc * 2; return st * 1024 + (ob ^ (((ob >> 9) & 1) << 5)); }
__host__ __device__ __forceinline__ void stage_rc(int b, int& R, int& C) { const int st = b / 1024, sb = b % 1024, swz = sb ^ (((sb >> 9) & 1) << 5); R = (st >> 1) * 16 + swz / 64; C = (st & 1) * 32 + (swz % 64) / 2; }
__host__ __device__ __forceinline__ int perm32(int rho) { const int n = rho >> 4, i = rho & 15; return 8 * (i >> 2) + 4 * n + (i & 3); }
struct Unit { int pm, pn; };
struct Gemm { const bf16_t* A; const bf16_t* Bt; int M, N, K; };
struct StaticOrder {
    int nM, nN, nwg, G, c, wgm;
    __host__ __device__ void init(int M, int N, int G_, int c_, int wgm_ = WGM) { nM = M / BM; nN = N / BM; nwg = nM * nN; G = G_; c = c_; wgm = wgm_; }
    __host__ __device__ bool next(int i, Unit& u) const {
        const long L = (long)i * G + c; if (L >= nwg) return false;
        int wgid = (int)L; { const int q = nwg / NXCD, r = nwg % NXCD, xcd = wgid % NXCD, off = wgid / NXCD; wgid = (xcd < r ? xcd * (q + 1) : r * (q + 1) + (xcd - r) * q) + off; }
        const int nig = wgm * nN, gid = wgid / nig, fm = gid * wgm, gsz = (nM - fm) < wgm ? (nM - fm) : wgm;
        u.pm = fm + ((wgid % nig) % gsz); u.pn = (wgid % nig) / gsz; return true;
    }
    __device__ __forceinline__ void a_ready(const Unit&) const {}
    __device__ __forceinline__ void done(const Unit&) const {}
};

template <class Epi, class Sched>
__device__ __forceinline__ void gemm_phase(LAS unsigned char* lds, const Gemm g, const Sched& S, const Epi& E) {
    int tid_ = threadIdx.x; asm volatile("" : "+v"(tid_));
    const int tid = tid_, wid = __builtin_amdgcn_readfirstlane(tid >> 6), lane = tid & 63, wr = wid >> 2, wc = wid & 3, fr = lane & 15, fq = lane >> 4;
    const int K = g.K, nt = K / BK;
    unsigned voffA[2], voffB[2];
#pragma unroll
    for (int i = 0; i < 2; ++i) { int R, C; stage_rc(tid * 16 + i * 8192, R, C); const int Rb = Epi::PERM ? ((R & ~31) + perm32(R & 31)) : R;
        voffA[i] = (unsigned)(R * K + C) * 2u; voffB[i] = (unsigned)(Rb * K + C) * 2u; }
    const size_t kstep = (size_t)(BK * 2);
    const size_t hstep = (size_t)HALF * K * 2;
    const size_t tstep = 2 * hstep;
    const unsigned ldsw = (unsigned)wid * 1024u;
    const int aoff = lds_byte(wr * 64 + fr, fq * 8), boff = lds_byte(wc * 32 + fr, fq * 8);
#define PG8_SA(b, h) (((b) * 2 + (h)) * HTB)
#define PG8_SB(b, h) ((4 + (b) * 2 + (h)) * HTB)
#define PG8_STAGE(bufoff, gbase, voff) do { _Pragma("unroll") for (int _i = 0; _i < 2; ++_i) \
        __builtin_amdgcn_global_load_lds((const unsigned*)((const char*)(gbase) + (voff)[_i]), (LAS unsigned*)(lds + (bufoff) + ldsw + _i * 8192), 16, 0, 0); } while (0)
#define PG8_LDA(dst, b, h) do { _Pragma("unroll") for (int m = 0; m < 4; ++m) _Pragma("unroll") for (int k = 0; k < 2; ++k) dst[m][k] = *(const LAS bf16x8*)(lds + PG8_SA(b, h) + aoff + m * 2048 + k * 1024); } while (0)
#define PG8_LDB(dst, b, h) do { _Pragma("unroll") for (int n = 0; n < 2; ++n) _Pragma("unroll") for (int k = 0; k < 2; ++k) dst[n][k] = *(const LAS bf16x8*)(lds + PG8_SB(b, h) + boff + n * 2048 + k * 1024); } while (0)
#define PG8_MMA(ai, bj, At, Bt) do { __builtin_amdgcn_s_setprio(1); _Pragma("unroll") for (int m = 0; m < 4; ++m) _Pragma("unroll") for (int n = 0; n < 2; ++n) _Pragma("unroll") for (int k = 0; k < 2; ++k) \
        acc[ai][bj][m][n] = __builtin_amdgcn_mfma_f32_16x16x32_bf16(Bt[n][k], At[m][k], acc[ai][bj][m][n], 0, 0, 0); __builtin_amdgcn_s_setprio(0); } while (0)
#define PG8_WAIT_V(n) asm volatile("s_waitcnt vmcnt(" #n ")" ::: "memory")
#define PG8_WAIT_L(n) asm volatile("s_waitcnt lgkmcnt(" #n ")" ::: "memory")
#define PG8_BAR __builtin_amdgcn_s_barrier()
#define PG8_SCHED __builtin_amdgcn_sched_barrier(0)
    Unit cur, nxt; int ui = 0;
    if (!S.next(0, cur)) return;
    f32x4 acc[2][2][4][2];
#pragma unroll
    for (int a = 0; a < 2; ++a)
#pragma unroll
        for (int b = 0; b < 2; ++b)
#pragma unroll
            for (int m = 0; m < 4; ++m)
#pragma unroll
                for (int n = 0; n < 2; ++n) acc[a][b][m][n] = (f32x4){0.f, 0.f, 0.f, 0.f};
    bf16x8 At[4][2], B0[2][2], B1[2][2];
    const char* cA = (const char*)g.A + (size_t)cur.pm * tstep; const char* cB = (const char*)g.Bt + (size_t)cur.pn * tstep;
    S.a_ready(cur);
    PG8_STAGE(PG8_SB(0, 0), cB, voffB); PG8_STAGE(PG8_SA(0, 0), cA, voffA); PG8_STAGE(PG8_SB(0, 1), cB + hstep, voffB); PG8_STAGE(PG8_SA(0, 1), cA + hstep, voffA);
    if (wr == 1) PG8_BAR;
    PG8_WAIT_V(4); PG8_BAR;
    PG8_STAGE(PG8_SB(1, 0), cB + kstep, voffB); PG8_STAGE(PG8_SA(1, 0), cA + kstep, voffA); PG8_STAGE(PG8_SB(1, 1), cB + hstep + kstep, voffB);
    PG8_WAIT_V(6); PG8_BAR;
    for (;;) {
        const bool has_next = S.next(ui + 1, nxt);
        const char* nA = has_next ? (const char*)g.A + (size_t)nxt.pm * tstep : cA; const char* nB = has_next ? (const char*)g.Bt + (size_t)nxt.pn * tstep : cB;
        for (int t = 0; t < nt; t += 2) {
            const bool last = (t == nt - 2);
            const char* a1 = cA + (size_t)(t + 1) * kstep;
            const char* a2 = last ? nA : cA + (size_t)(t + 2) * kstep; const char* b2 = last ? nB : cB + (size_t)(t + 2) * kstep;
            const char* a3 = a2 + kstep; const char* b3 = b2 + kstep;
            if (last && has_next) S.a_ready(nxt);
            PG8_LDB(B0, 0, 0); PG8_SCHED; PG8_LDA(At, 0, 0); PG8_STAGE(PG8_SA(1, 1), a1 + hstep, voffA);
            PG8_WAIT_L(8); PG8_BAR; PG8_WAIT_L(0); PG8_MMA(0, 0, At, B0); PG8_BAR; PG8_SCHED;
            PG8_LDB(B1, 0, 1); PG8_STAGE(PG8_SB(0, 0), b2, voffB);
            PG8_BAR; PG8_WAIT_L(0); PG8_MMA(0, 1, At, B1); PG8_BAR;
            PG8_LDA(At, 0, 1); PG8_STAGE(PG8_SA(0, 0), a2, voffA);
            PG8_BAR; PG8_WAIT_L(0); PG8_MMA(1, 0, At, B0); PG8_BAR; PG8_SCHED;
            PG8_STAGE(PG8_SB(0, 1), b2 + hstep, voffB);
            PG8_WAIT_V(6); PG8_BAR; PG8_MMA(1, 1, At, B1); PG8_BAR;
            PG8_LDB(B0, 1, 0); PG8_SCHED; PG8_LDA(At, 1, 0); PG8_STAGE(PG8_SA(0, 1), a2 + hstep, voffA);
            PG8_WAIT_L(8); PG8_BAR; PG8_WAIT_L(0); PG8_MMA(0, 0, At, B0); PG8_BAR; PG8_SCHED;
            PG8_LDB(B1, 1, 1); PG8_STAGE(PG8_SB(1, 0), b3, voffB);
            PG8_BAR; PG8_WAIT_L(0); PG8_MMA(0, 1, At, B1); PG8_BAR;
            PG8_LDA(At, 1, 1); PG8_STAGE(PG8_SA(1, 0), a3, voffA);
            PG8_BAR; PG8_WAIT_L(0); PG8_MMA(1, 0, At, B0); PG8_BAR; PG8_SCHED;
            PG8_STAGE(PG8_SB(1, 1), b3 + hstep, voffB);
            PG8_WAIT_V(6); PG8_BAR; PG8_MMA(1, 1, At, B1); PG8_BAR;
        }
        E(acc, cur, wr, wc, fr, fq); S.done(cur);
        if (!has_next) break;
#pragma unroll
        for (int a = 0; a < 2; ++a)
#pragma unroll
            for (int b = 0; b < 2; ++b)
#pragma unroll
                for (int m = 0; m < 4; ++m)
#pragma unroll
                    for (int n = 0; n < 2; ++n) acc[a][b][m][n] = (f32x4){0.f, 0.f, 0.f, 0.f};
        cur = nxt; cA = nA; cB = nB; ++ui;
    }
    PG8_WAIT_V(0);
    if (wr == 0) PG8_BAR;
    PG8_BAR;
#undef PG8_SA
#undef PG8_SB
#undef PG8_STAGE
#undef PG8_LDA
#undef PG8_LDB
#undef PG8_MMA
#undef PG8_WAIT_V
#undef PG8_WAIT_L
#undef PG8_BAR
#undef PG8_SCHED
}
}

template <int ACT  > struct EpiBf16 {
    static constexpr bool PERM = true;
    bf16_t* O; int ldc; float* gate;
    __device__ __forceinline__ void operator()(const f32x4 (&acc)[2][2][4][2], const pg8::Unit& u, int wr, int wc, int fr, int fq) const {
        const int row0 = u.pm * 256 + wr * 64 + fr; const int col0 = u.pn * 256 + wc * 32 + 8 * fq;
#pragma unroll
        for (int ai = 0; ai < 2; ++ai)
#pragma unroll
            for (int m = 0; m < 4; ++m) { const int row = row0 + ai * 128 + m * 16; bf16_t* rowp = O + (size_t)row * ldc + col0;
#pragma unroll
                for (int bj = 0; bj < 2; ++bj) { f32x4 v0 = acc[ai][bj][m][0], v1 = acc[ai][bj][m][1];
                    if (ACT == 1) {
#pragma unroll
                        for (int j = 0; j < 4; ++j) { float a = fmaxf(v0[j], 0.f), b = fmaxf(v1[j], 0.f); v0[j] = a * a; v1[j] = b * b; } }
                    if (ACT == 0) { if (u.pn == (C_G / 256) && bj == 0 && wc == 0 && fq < 2) { float* gp = gate + (size_t)row * 16 + 8 * fq; *(f32x4*)gp = v0; *(f32x4*)(gp + 4) = v1; } }
                    u32x4 w; w.x = cvt_pk_bf16(v0[0], v0[1]); w.y = cvt_pk_bf16(v0[2], v0[3]); w.z = cvt_pk_bf16(v1[0], v1[1]); w.w = cvt_pk_bf16(v1[2], v1[3]);
                    *(u32x4*)(rowp + bj * 128) = w; } }
    }
};
struct EpiRes {
    static constexpr bool PERM = false;
    const float* xi; float* xo; const float* ci; float* co; const float* mod; int slot;
    __device__ __forceinline__ void operator()(const f32x4 (&acc)[2][2][4][2], const pg8::Unit& u, int wr, int wc, int fr, int fq) const {
        const int row0 = u.pm * 256 + wr * 64 + fr; const int col0 = u.pn * 256 + wc * 32 + 4 * fq;
#pragma unroll
        for (int ai = 0; ai < 2; ++ai)
#pragma unroll
            for (int m = 0; m < 4; ++m) { const int row = row0 + ai * 128 + m * 16;
                const float* ip; float* op; int b;
                if (row < ML_ROWS) { b = row >> 11; ip = xi + (size_t)row * D; op = xo + (size_t)row * D; }
                else { b = 8; ip = ci + (size_t)(row - ML_ROWS) * D; op = co + (size_t)(row - ML_ROWS) * D; }
                const float* gp = mod + (size_t)b * 12288 + slot * 2048;
#pragma unroll
                for (int bj = 0; bj < 2; ++bj)
#pragma unroll
                    for (int n = 0; n < 2; ++n) { const int c = col0 + bj * 128 + n * 16;
                        const f32x4 r = *(const f32x4*)(ip + c), g = *(const f32x4*)(gp + c);
                        *(f32x4*)(op + c) = r + g * acc[ai][bj][m][n]; } }
    }
};

struct WtJob { const float* W; bf16_t* WT; int K, N, kt, nt; };
__device__ __forceinline__ WtJob wt_job(const Params& p, int it) {
    constexpr int T_IN = 32 * 112, T_OUT = 32 * 32, T_FF1 = 32 * 128, T_FF2 = 128 * 32, T_L = T_IN + T_OUT + T_FF1 + T_FF2;
    const int l = it / T_L; int r = it % T_L; bf16_t* wt = (bf16_t*)(p.ws + WS_WT + (size_t)l * WT_LAYER); WtJob j;
    if (r < T_IN) { j.W = p.in[I_WIN] + (size_t)l * 2048 * NIN; j.WT = wt + WT_IN_OFF / 2; j.K = 2048; j.N = NIN; j.kt = r % 32; j.nt = r / 32; }
    else if ((r -= T_IN) < T_OUT) { j.W = p.in[I_WOUT] + (size_t)l * 2048 * 2048; j.WT = wt + WT_OUT_OFF / 2; j.K = 2048; j.N = 2048; j.kt = r % 32; j.nt = r / 32; }
    else if ((r -= T_OUT) < T_FF1) { j.W = p.in[I_WFF1] + (size_t)l * 2048 * 8192; j.WT = wt + WT_FF1_OFF / 2; j.K = 2048; j.N = 8192; j.kt = r % 32; j.nt = r / 32; }
    else { r -= T_FF1; j.W = p.in[I_WFF2] + (size_t)l * 8192 * 2048; j.WT = wt + WT_FF2_OFF / 2; j.K = 8192; j.N = 2048; j.kt = r % 128; j.nt = r / 128; }
    return j;
}
__device__ __forceinline__ void phase_prologue(const Params& p, LAS unsigned char* lds) {
    const int tid = opaque_tid(), G = gridDim.x, bid = blockIdx.x;
    unsigned char* ws = p.ws;
    { float* rc = (float*)(ws + WS_ROPE); float* rs = rc + 2048 * 48;
      for (int i = bid * NTHREADS + tid; i < 2048 * 48; i += G * NTHREADS) { const int t = i / 48, a = i % 48; const int f = a % 24;
          const float inv = powf(10000.0f, -(float)f / 24.0f); const float pos = (a < 24) ? (float)(t / 64) : (float)(t % 64); const float ang = pos * inv;
          rc[i] = cosf(ang); rs[i] = sinf(ang); } }
    { LAS float* sl = (LAS float*)lds; LAS float* red = sl + 9 * 2048;
      bool loaded = false;
      for (int item = bid; item < 384; item += G) {
          if (!loaded) { for (int i = tid; i < 9 * 2048; i += NTHREADS) { const float v = (i < 8 * 2048) ? p.in[I_C][i] : p.in[I_CCTX][i - 8 * 2048]; sl[i] = siluf(v); } loaded = true; __syncthreads(); }
          const int l = item / 192, n0 = (item % 192) * 64; const int kq = tid >> 6, col = tid & 63;
          const float* W = p.in[I_WMOD] + (size_t)l * 2048 * 12288 + n0 + col;
          float acc[9];
#pragma unroll
          for (int r = 0; r < 9; ++r) acc[r] = 0.f;
          for (int k0 = kq * 256; k0 < kq * 256 + 256; k0 += 16) { float w[16];
#pragma unroll
              for (int i = 0; i < 16; ++i) w[i] = W[(size_t)(k0 + i) * 12288];
#pragma unroll
              for (int i4 = 0; i4 < 4; ++i4)
#pragma unroll
                  for (int r = 0; r < 9; ++r) { const f32x4 s = *(const LAS f32x4*)(sl + r * 2048 + k0 + i4 * 4); acc[r] += s[0] * w[i4 * 4] + s[1] * w[i4 * 4 + 1] + s[2] * w[i4 * 4 + 2] + s[3] * w[i4 * 4 + 3]; } }
#pragma unroll
          for (int r = 0; r < 9; ++r) red[(kq * 9 + r) * 64 + col] = acc[r];
          __syncthreads();
          for (int idx = tid; idx < 576; idx += NTHREADS) { const int r = idx >> 6, cc = idx & 63; float s = 0.f;
#pragma unroll
              for (int q = 0; q < 8; ++q) s += red[(q * 9 + r) * 64 + cc];
              ((float*)(ws + WS_MOD))[((size_t)l * 9 + r) * 12288 + n0 + cc] = s + p.in[I_BMOD][l * 12288 + n0 + cc]; }
          __syncthreads();
      }
      __syncthreads();
    }
    { LAS float* z = (LAS float*)lds; LAS float* h1 = z + 8 * 36;
      for (int item = bid; item < 544; item += G) {
          int l, Ls, i0; float* HD;
          if (item < 512) { l = item >> 8; Ls = SEQ; i0 = (item & 255) * 8; HD = (float*)(ws + WS_HD) + (size_t)l * 2048 * 64; }
          else { l = 0; Ls = LC; i0 = (item - 512) * 8; HD = (float*)(ws + WS_HD) + (size_t)2 * 2048 * 64; }
          if (tid < 264) { const int pos = tid / 33, e = tid % 33; const int i = i0 + pos;
              const float t = (float)i / (float)(Ls - 1); const float w = (6.283185307179586f / (float)Ls) * (float)i; float v;
              if (e == 0) v = t; else { const int k = (e - 1) & 15; const float band = 1e-4f + (float)k * ((15.0f - 1e-4f) / 15.0f); const float a = band * w; v = (e <= 16) ? cosf(a) : -sinf(a); }
              z[pos * 36 + e] = v; }
          __syncthreads();
          const int pos = tid >> 6, j = tid & 63;
          { float s = p.in[I_HB1][l * 64 + j]; const float* w1 = p.in[I_HW1] + (size_t)l * 33 * 64 + j;
            for (int e = 0; e < 33; ++e) s += z[pos * 36 + e] * w1[e * 64];
            h1[pos * 64 + j] = sinf(p.in[I_HFREQ][l * 64 + j] * s); }
          __syncthreads();
          { float s = p.in[I_HB2][l * 64 + j]; const float* w2 = p.in[I_HW2] + (size_t)l * 64 * 64 + j;
            for (int e = 0; e < 64; ++e) s += h1[pos * 64 + e] * w2[e * 64];
            HD[(size_t)(i0 + pos) * 64 + j] = sinf(p.in[I_HFREQ][l * 64 + j] * s); }
          __syncthreads();
      }
    }
    { LAS float* tile = (LAS float*)lds;
      constexpr int T_ALL = 2 * (32 * 112 + 32 * 32 + 32 * 128 + 128 * 32);
      for (int it0 = bid * 4; it0 < T_ALL; it0 += G * 4) {
          float4 v[4][2];
#pragma unroll
          for (int q = 0; q < 4; ++q) { const WtJob j = wt_job(p, it0 + q); const int k0 = j.kt * 64, n0 = j.nt * 64;
#pragma unroll
              for (int pp = 0; pp < 2; ++pp) { const int kk = (tid >> 4) + pp * 32, n4 = (tid & 15) * 4;
                  v[q][pp] = make_float4(0.f, 0.f, 0.f, 0.f);
                  if (n0 + n4 < j.N) v[q][pp] = *(const float4*)(j.W + (size_t)(k0 + kk) * j.N + n0 + n4); } }
#pragma unroll
          for (int q = 0; q < 4; ++q)
#pragma unroll
              for (int pp = 0; pp < 2; ++pp) { const int kk = (tid >> 4) + pp * 32, n4 = (tid & 15) * 4; LAS float* t = tile + q * 64 * 65;
                  t[(n4 + 0) * 65 + kk] = v[q][pp].x; t[(n4 + 1) * 65 + kk] = v[q][pp].y; t[(n4 + 2) * 65 + kk] = v[q][pp].z; t[(n4 + 3) * 65 + kk] = v[q][pp].w; }
          __syncthreads();
#pragma unroll
          for (int q = 0; q < 4; ++q) { const WtJob j = wt_job(p, it0 + q); const int k0 = j.kt * 64, n0 = j.nt * 64; const int nn = tid >> 3, k8 = (tid & 7) * 8; float f[8];
#pragma unroll
              for (int i = 0; i < 8; ++i) f[i] = tile[q * 64 * 65 + nn * 65 + k8 + i];
              *(u32x4*)(j.WT + (size_t)(n0 + nn) * j.K + k0 + k8) = pack8(f); }
          __syncthreads();
      }
    }
}

__device__ __forceinline__ void filter_items(const Params& p, LAS unsigned char* lds, int item0, int stride) {
    const int tid = opaque_tid(); unsigned char* ws = p.ws;
    LAS float* hd = (LAS float*)lds;
    LAS float* red = hd + 256 * 64;
    for (int item = item0; item < 136; item += stride) {
        int l, cg, isl, Ls; const float* HD; float* FX; float* NP;
        if (item < 128) { l = item >> 6; cg = (item >> 3) & 7; isl = item & 7; Ls = SEQ; HD = (const float*)(ws + WS_HD) + (size_t)l * 2048 * 64; FX = (float*)(ws + WS_FX) + (size_t)l * 4096 * 512;
            NP = (float*)(ws + WS_NORM) + (size_t)(l * 8 + isl) * 512; }
        else { l = 0; cg = item - 128; isl = 0; Ls = LC; HD = (const float*)(ws + WS_HD) + (size_t)2 * 2048 * 64; FX = (float*)(ws + WS_FC); NP = (float*)(ws + WS_NORM) + (size_t)16 * 512; }
        const int i0 = isl * 256;
        __syncthreads();
        for (int i = tid; i < 256 * 64; i += NTHREADS) hd[i] = HD[(size_t)i0 * 64 + i];
        __syncthreads();
        const int c = tid & 63, dir = (tid >> 6) & 1, sub = tid >> 7; const int ch = cg * 64 + c;
        float w3[64];
        { const float* w3p = p.in[I_HW3] + (size_t)l * 64 * 1024 + dir * 512 + ch;
#pragma unroll
          for (int j = 0; j < 64; ++j) w3[j] = w3p[j * 1024]; }
        const float lo = -4.605170185988091f / 1.5f, hi = -4.605170185988091f / 0.3f;
        const float delta = fabsf(lo + (float)ch * ((hi - lo) / 511.0f));
        float asum = 0.f;
        for (int ii = 0; ii < 64; ++ii) { const int li = sub * 64 + ii; const int pos = i0 + li;
            float dot = 0.f;
#pragma unroll
            for (int j4 = 0; j4 < 16; ++j4) { const f32x4 h = *(const LAS f32x4*)(hd + li * 64 + j4 * 4);
                dot += h[0] * w3[j4 * 4] + h[1] * w3[j4 * 4 + 1] + h[2] * w3[j4 * 4 + 2] + h[3] * w3[j4 * 4 + 3]; }
            const float t = (float)pos / (float)(Ls - 1);
            const float val = dot * __expf(-t * delta);
            if (!(dir == 1 && pos == 0)) { const int lag = dir ? -pos : pos; FX[(size_t)(lag + Ls - 1) * 512 + ch] = val; asum += fabsf(val); } }
        red[(tid >> 6) * 64 + c] = asum;
        __syncthreads();
        if (tid < 64) { float s = 0.f;
#pragma unroll
            for (int q = 0; q < 8; ++q) s += red[q * 64 + tid];
            NP[cg * 64 + tid] = s; }
    }
    __syncthreads();
}

__device__ __forceinline__ void phase_norm_mod(const float* __restrict__ xl, const float* __restrict__ xc, const float* __restrict__ g, const float* __restrict__ mod, int slot_shift, int nrows, bf16_t* __restrict__ act) {
    const int tidq = opaque_tid(); const int lane = tidq & 63; const int nw = gridDim.x * 8;
    const int vbq = (gridDim.x % 8 == 0) ? (blockIdx.x & 7) * (gridDim.x >> 3) + (blockIdx.x >> 3) : blockIdx.x; const int gw = vbq * 8 + (tidq >> 6);
    const int per = (nrows + nw - 1) / nw; const int r0 = gw * per; const int r1 = (r0 + per < nrows) ? r0 + per : nrows;
    int curb = -1; f32x4 fa[8], fb[8];
    for (int row = r0; row < r1; row += 2) {
        const bool two = row + 1 < r1; const int rowb = two ? row + 1 : row;
        const float* s0 = (row < ML_ROWS) ? xl + (size_t)row * D : xc + (size_t)(row - ML_ROWS) * D;
        const float* s1 = (rowb < ML_ROWS) ? xl + (size_t)rowb * D : xc + (size_t)(rowb - ML_ROWS) * D;
        f32x4 v0[8], v1[8]; float ss0 = 0.f, ss1 = 0.f;
#pragma unroll
        for (int i = 0; i < 8; ++i) { v0[i] = *(const f32x4*)(s0 + i * 256 + lane * 4); v1[i] = *(const f32x4*)(s1 + i * 256 + lane * 4); }
#pragma unroll
        for (int i = 0; i < 8; ++i) { ss0 += v0[i][0] * v0[i][0] + v0[i][1] * v0[i][1] + v0[i][2] * v0[i][2] + v0[i][3] * v0[i][3]; ss1 += v1[i][0] * v1[i][0] + v1[i][1] * v1[i][1] + v1[i][2] * v1[i][2] + v1[i][3] * v1[i][3]; }
        ss0 = wave_sum(ss0); ss1 = wave_sum(ss1);
#pragma unroll
        for (int h = 0; h < 2; ++h) { if (h == 1 && !two) break;
            const int rr = h ? rowb : row; const int b = (rr < ML_ROWS) ? (rr >> 11) : 8;
            if (b != curb) { curb = b; const float* sh = mod + (size_t)b * 12288 + slot_shift * 2048; const float* sc = sh + 2048;
#pragma unroll
                for (int i = 0; i < 8; ++i) { const int c = i * 256 + lane * 4; const f32x4 gg = *(const f32x4*)(g + c), s1v = *(const f32x4*)(sc + c); fb[i] = *(const f32x4*)(sh + c); fa[i] = gg * (s1v + 1.0f); } }
            const float r = rsqrtf((h ? ss1 : ss0) * (1.0f / D) + EPS);
#pragma unroll
            for (int i = 0; i < 8; ++i) { const int c = i * 256 + lane * 4; const f32x4 x = h ? v1[i] : v0[i]; const f32x4 o = (x * r) * fa[i] + fb[i];
                u32x2 w; w.x = cvt_pk_bf16(o[0], o[1]); w.y = cvt_pk_bf16(o[2], o[3]);
                *(u32x2*)(act + (size_t)rr * D + c) = w; } }
    }
}

__device__ __forceinline__ void phase_qk(const Params& p, int l) {
    const int tidq = opaque_tid(); unsigned char* ws = p.ws;
    const bf16_t* P = (const bf16_t*)(ws + WS_PH); bf16_t* QK = (bf16_t*)(ws + WS_ACT) + 512;
    const float* cw = p.in[I_MLCW] + (size_t)l * 3 * 1536;
    const int nunits = (MT_ROWS / 4) * 192;
    for (int u = blockIdx.x * NTHREADS + tidq; u < nunits; u += gridDim.x * NTHREADS) { const int cg = u % 192, r0 = (u / 192) * 4; const int c0 = cg * 8;
        const int seg_lo = (r0 < ML_ROWS) ? (r0 & ~2047) : (ML_ROWS + ((r0 - ML_ROWS) & ~255)); const int seg_hi = seg_lo + ((r0 < ML_ROWS) ? SEQ : LC);
        u32x4 raw[6];
#pragma unroll
        for (int t = 0; t < 6; ++t) { const int row = r0 - 1 + t; raw[t] = (row >= seg_lo && row < seg_hi) ? *(const u32x4*)(P + (size_t)row * NINP + C_MLQ + c0) : (u32x4){0u, 0u, 0u, 0u}; }
        float w0[8], w1[8], w2[8];
#pragma unroll
        for (int i = 0; i < 8; ++i) { w0[i] = cw[c0 + i]; w1[i] = cw[1536 + c0 + i]; w2[i] = cw[3072 + c0 + i]; }
        const float sc = (c0 >= 768) ? 0.07216878364870322f : 1.0f;
#pragma unroll
        for (int rr = 0; rr < 4; ++rr) { float xa[8], xb[8], xc[8], o[8]; unpack8(raw[rr], xa); unpack8(raw[rr + 1], xb); unpack8(raw[rr + 2], xc);
#pragma unroll
            for (int i = 0; i < 8; ++i) { const float v = w0[i] * xa[i] + w1[i] * xb[i] + w2[i] * xc[i]; o[i] = siluf(v) * sc; }
            *(u32x4*)(QK + (size_t)(r0 + rr) * D + c0) = pack8(o); } }
}

__device__ __forceinline__ f32x4 mfma16(const bf16x8 a, const bf16x8 b, const f32x4 c) { return __builtin_amdgcn_mfma_f32_16x16x32_bf16(a, b, c, 0, 0, 0); }

template <int DK, int NT, bool IS_ML>
__device__ __forceinline__ void scan_chain(const Params& p, int l, int item, LAS unsigned char* lds) {
    constexpr int LDQ = DK + 8, LDS2 = 136, LDC = DK + 8, KS = DK / 32, DPG = IS_ML ? 6 : 3, CG8 = DK / 8;
    constexpr int R0B = (128 * LDQ * 2 > 128 * LDS2 * 2) ? 128 * LDQ * 2 : 128 * LDS2 * 2;
    constexpr int R1B = (128 * LDQ * 2 > DK * LDS2 * 2) ? 128 * LDQ * 2 : DK * LDS2 * 2;
    constexpr int R2B = NT * 16 * LDS2 * 2, R3B = NT * 16 * LDC * 2;
    constexpr int NKR = (128 * CG8 + NTHREADS - 1) / NTHREADS;
    LAS bf16_t* Qs = (LAS bf16_t*)lds;
    LAS bf16_t* Ks = (LAS bf16_t*)(lds + R0B);
    LAS bf16_t* Vt = (LAS bf16_t*)(lds + R0B + R1B);
    LAS bf16_t* Ct = (LAS bf16_t*)(lds + R0B + R1B + R2B);
    LAS float* vec = (LAS float*)(lds + R0B + R1B + R2B + R3B);
    LAS float* colterm = vec; LAS float* rowterm = vec + 128; LAS float* winter = vec + 256; LAS float* wkv = vec + 384; LAS float* oscale = vec + 512; LAS float* scal = vec + 640;
    static_assert(R0B + R1B + R2B + R3B + 656 * 4 <= LDS_BYTES - 64, "LDS");

    int tid_ = threadIdx.x; asm volatile("" : "+v"(tid_));
    const int tid = tid_, wid = __builtin_amdgcn_readfirstlane(tid >> 6), lane = tid & 63, fr = lane & 15, fq = lane >> 4;
    const int sl = item & 3, dir = (item >> 2) & 1, h = (item >> 3) & 3, b = item >> 5;
    unsigned char* ws = p.ws;
    const bf16_t* P = (const bf16_t*)(ws + WS_PH);
    bf16_t* OUT = (bf16_t*)(ws + (IS_ML ? WS_OM : WS_OR) + (size_t)dir * OMR_DIR);
    const float* GATE = (const float*)(ws + WS_GATE);
    const float* ropec = (const float*)(ws + WS_ROPE); const float* ropes = ropec + 2048 * 48;

    __syncthreads();
    for (int i = tid; i < NT * 16 * LDC / 2; i += NTHREADS) ((LAS unsigned*)Ct)[i] = 0u;
    if (IS_ML) { for (int u = tid; u < 16 * 128; u += NTHREADS) { const int e = 48 + (u >> 7), j = u & 127; Vt[e * LDS2 + j] = (e == 48) ? (bf16_t)0x3F80 : (bf16_t)0; } }
    if (!IS_ML) { const float lg = -__expf(p.in[I_RTLD][l * 8 + dir * 4 + h]);
        if (tid < 128) { const float j = (float)tid; colterm[tid] = __expf(-lg * j); rowterm[tid] = __expf(lg * j); winter[tid] = __expf(lg * (j + 1.0f)); wkv[tid] = __expf(lg * (127.0f - j)); oscale[tid] = 0.f; }
        if (tid == 0) { scal[0] = __expf(lg * 128.0f); scal[1] = 0.f; } }
    if (IS_ML && tid == 0) { float one = 1.0f, zero = 0.f; asm volatile("" : "+v"(one), "+v"(zero)); scal[0] = one; scal[1] = zero; }
    f32x4 accC[DPG];
#pragma unroll
    for (int i = 0; i < DPG; ++i) accC[i] = (f32x4){0.f, 0.f, 0.f, 0.f};
    float gbi = 0.f, gbf = 0.f;
    if (IS_ML) { gbi = p.in[I_MLGB][l * 16 + dir * 8 + h]; gbf = p.in[I_MLGB][l * 16 + dir * 8 + 4 + h]; }
    __syncthreads();

    const int tid_chain = tid;
    for (int step = 0; step < 18; ++step) {
        int tq_ = tid_chain; asm volatile("" : "+v"(tq_));
        const int tid = tq_, wid = __builtin_amdgcn_readfirstlane(tid >> 6), lane = tid & 63, fr = lane & 15, fq = lane >> 4;
        const bool isctx = step < 2; const int nch = isctx ? 2 : 16; const int ci = isctx ? step : step - 2; const int chunk = dir ? (nch - 1 - ci) : ci;
        const int seg_lo = isctx ? (ML_ROWS + b * LC) : b * SEQ; const int seg_hi = seg_lo + (isctx ? LC : SEQ);
        const int rowbase = seg_lo + chunk * 128;
        u32x4 vreg[2]; float g_i = 0.f, g_f = 0.f;
        { const int vc = (IS_ML ? C_MLV : C_RV) + h * 192 + sl * 48;
#pragma unroll
          for (int k = 0; k < 2; ++k) { const int u = tid + k * NTHREADS; vreg[k] = (u32x4){0u, 0u, 0u, 0u};
              if (u < 128 * 6) { const int j = u & 127, e0 = (u >> 7) * 8; const int row = dir ? rowbase + 127 - j : rowbase + j; vreg[k] = *(const u32x4*)(P + (size_t)row * NINP + vc + e0); } }
          if (IS_ML && tid < 128) { const int row = dir ? rowbase + 127 - tid : rowbase + tid; g_i = GATE[(size_t)row * 16 + dir * 8 + h]; g_f = GATE[(size_t)row * 16 + dir * 8 + 4 + h]; } }
        if (IS_ML) {
            { const bf16_t* QK = (const bf16_t*)(ws + WS_ACT) + 512 + h * 192; u32x4 raw[12];
#pragma unroll
              for (int k = 0; k < 12; ++k) { const int u = tid + k * NTHREADS; const int cgq = u % 48, rch = u / 48; raw[k] = *(const u32x4*)(QK + (size_t)(rowbase + rch) * D + ((cgq >= 24) ? 768 : 0) + (cgq % 24) * 8); }
#pragma unroll
              for (int k = 0; k < 12; ++k) { const int u = tid + k * NTHREADS; const int cgq = u % 48, rch = u / 48; const int j = dir ? 127 - rch : rch;
                  *(LAS u32x4*)(((cgq >= 24) ? Ks : Qs) + j * LDQ + (cgq % 24) * 8) = raw[k]; } }
        } else {
            for (int u = tid; u < 128 * 6; u += NTHREADS) { const int j = u / 6, d0 = (u % 6) * 8; const int row = dir ? rowbase + 127 - j : rowbase + j;
                float cs[8], sn[8];
                if (!isctx) { const int t = row - seg_lo;
#pragma unroll
                    for (int i = 0; i < 8; ++i) { cs[i] = ropec[t * 48 + d0 + i]; sn[i] = ropes[t * 48 + d0 + i]; } }
                else {
#pragma unroll
                    for (int i = 0; i < 8; ++i) { cs[i] = 1.f; sn[i] = 0.f; } }
#pragma unroll
                for (int qk = 0; qk < 2; ++qk) { const int pc = (qk ? C_RK : C_RQ) + h * 96 + d0; const bf16_t* pr = P + (size_t)row * NINP + pc;
                    float a1[8], a2[8], o1[8], o2[8]; unpack8(*(const u32x4*)pr, a1); unpack8(*(const u32x4*)(pr + 48), a2);
                    const float sc = qk ? 1.0f : 0.10206207261596575f;
#pragma unroll
                    for (int i = 0; i < 8; ++i) { o1[i] = (a1[i] * cs[i] - a2[i] * sn[i]) * sc; o2[i] = (a1[i] * sn[i] + a2[i] * cs[i]) * sc; }
                    LAS bf16_t* dst = (qk ? Ks : Qs) + j * LDQ + d0;
                    *(LAS u32x4*)dst = pack8(o1); *(LAS u32x4*)(dst + 48) = pack8(o2); } }
        }
#pragma unroll
        for (int k = 0; k < 2; ++k) { const int u = tid + k * NTHREADS; if (u < 128 * 6) { const int j = u & 127, e0 = (u >> 7) * 8; const u32x4 v = vreg[k];
              Vt[(e0 + 0) * LDS2 + j] = (bf16_t)(v.x & 0xFFFFu); Vt[(e0 + 1) * LDS2 + j] = (bf16_t)(v.x >> 16);
              Vt[(e0 + 2) * LDS2 + j] = (bf16_t)(v.y & 0xFFFFu); Vt[(e0 + 3) * LDS2 + j] = (bf16_t)(v.y >> 16);
              Vt[(e0 + 4) * LDS2 + j] = (bf16_t)(v.z & 0xFFFFu); Vt[(e0 + 5) * LDS2 + j] = (bf16_t)(v.z >> 16);
              Vt[(e0 + 6) * LDS2 + j] = (bf16_t)(v.w & 0xFFFFu); Vt[(e0 + 7) * LDS2 + j] = (bf16_t)(v.w >> 16); } }
        if (IS_ML) { if (tid < 128) { colterm[tid] = g_i + gbi; const float gf = g_f + gbf; rowterm[tid] = fminf(gf, 0.f) - log1pf(__expf(-fabsf(gf))); } }
        __syncthreads();
        if (IS_ML) {
            if (wid == 0) {
                const float mprev = scal[1];
                const int j0 = 2 * lane, j1 = j0 + 1;
                const float i0 = colterm[j0], i1 = colterm[j1], f0 = rowterm[j0], f1 = rowterm[j1];
                float s = f0 + f1;
#pragma unroll
                for (int o = 1; o < 64; o <<= 1) { const float t = __shfl_up(s, o); if (lane >= o) s += t; }
                const float excl = s - (f0 + f1);
                const float b0 = excl + f0, b1 = excl + f0 + f1;
                const float a0 = i0 - b0, a1 = i1 - b1;
                float mx = fmaxf(a0, a1);
#pragma unroll
                for (int o = 1; o < 64; o <<= 1) { const float t = __shfl_up(mx, o); if (lane >= o) mx = fmaxf(mx, t); }
                float exm = __shfl_up(mx, 1); if (lane == 0) exm = -3.0e38f;
                const float M0 = fmaxf(fmaxf(mprev, exm), a0), M1 = fmaxf(M0, a1);
                const float Mlast = __shfl(M1, 63); const float bend = __shfl(b1, 63);
                colterm[j0] = a0; colterm[j1] = a1; rowterm[j0] = M0; rowterm[j1] = M1;
                winter[j0] = __expf(mprev - M0); winter[j1] = __expf(mprev - M1);
                wkv[j0] = __expf(a0 - Mlast); wkv[j1] = __expf(a1 - Mlast);
                oscale[j0] = __expf(-(b0 + M0)); oscale[j1] = __expf(-(b1 + M1));
                if (lane == 0) { scal[0] = __expf(mprev - Mlast); scal[1] = bend + Mlast; }
            }
            __syncthreads();
        }
        const float decay = scal[0];
        const int tt = (wid < 4) ? wid : 11 - wid;
        const int trow = 16 * tt + fr;
        bf16x8 qf[KS];
#pragma unroll
        for (int ks = 0; ks < KS; ++ks) qf[ks] = *(const LAS bf16x8*)(Qs + trow * LDQ + ks * 32 + fq * 8);
        f32x4 accO[NT];
        { bf16x8 cf[2][KS];
#pragma unroll
          for (int ks = 0; ks < KS; ++ks) cf[0][ks] = *(const LAS bf16x8*)(Ct + fr * LDC + ks * 32 + fq * 8);
#pragma unroll
          for (int nt = 0; nt < NT; ++nt) { accO[nt] = (f32x4){0.f, 0.f, 0.f, 0.f};
              if (nt + 1 < NT) {
#pragma unroll
                  for (int ks = 0; ks < KS; ++ks) cf[(nt + 1) & 1][ks] = *(const LAS bf16x8*)(Ct + (16 * (nt + 1) + fr) * LDC + ks * 32 + fq * 8); }
#pragma unroll
              for (int ks = 0; ks < KS; ++ks) accO[nt] = mfma16(cf[nt & 1][ks], qf[ks], accO[nt]); } }
        { const float wi = winter[trow];
#pragma unroll
          for (int nt = 0; nt < NT; ++nt) accO[nt] *= wi; }
        f32x4 accS[8];
        { bf16x8 kf[2][KS];
#pragma unroll
          for (int ks = 0; ks < KS; ++ks) kf[0][ks] = *(const LAS bf16x8*)(Ks + fr * LDQ + ks * 32 + fq * 8);
#pragma unroll
          for (int ns = 0; ns < 8; ++ns) { accS[ns] = (f32x4){0.f, 0.f, 0.f, 0.f};
              if (ns <= tt) {
                  if (ns + 1 <= tt && ns + 1 < 8) {
#pragma unroll
                      for (int ks = 0; ks < KS; ++ks) kf[(ns + 1) & 1][ks] = *(const LAS bf16x8*)(Ks + (16 * (ns + 1) + fr) * LDQ + ks * 32 + fq * 8); }
#pragma unroll
                  for (int ks = 0; ks < KS; ++ks) accS[ns] = mfma16(kf[ns & 1][ks], qf[ks], accS[ns]); } } }
        u32x4 kreg[NKR];
#pragma unroll
        for (int q = 0; q < NKR; ++q) { const int u = tid + q * NTHREADS; if (u < 128 * CG8) { const int j = u & 127, d0 = (u >> 7) * 8; kreg[q] = *(const LAS u32x4*)(Ks + j * LDQ + d0); } else kreg[q] = (u32x4){0u, 0u, 0u, 0u}; }
        __syncthreads();
        { const float rt = rowterm[trow];
#pragma unroll
          for (int ns = 0; ns < 8; ++ns) { u32x2 w = (u32x2){0u, 0u};
              if (ns <= tt) { float v[4]; const f32x4 ct = *(const LAS f32x4*)(colterm + 16 * ns + fq * 4);
#pragma unroll
                  for (int jj = 0; jj < 4; ++jj) { const int s = 16 * ns + fq * 4 + jj; const float e = (IS_ML ? __expf(fminf(ct[jj] - rt, 0.f)) : ct[jj] * rt) * ((s <= trow) ? 1.0f : 0.0f); v[jj] = accS[ns][jj] * e; }
                  w.x = cvt_pk_bf16(v[0], v[1]); w.y = cvt_pk_bf16(v[2], v[3]); }
              *(LAS u32x2*)(Qs + trow * LDS2 + 16 * ns + fq * 4) = w; } }
#pragma unroll
        for (int q = 0; q < NKR; ++q) { const int u = tid + q * NTHREADS; if (u < 128 * CG8) { const int j = u & 127, d0 = (u >> 7) * 8; float f[8]; unpack8(kreg[q], f); const float wk = wkv[j];
#pragma unroll
                for (int i = 0; i < 8; ++i) Ks[(d0 + i) * LDS2 + j] = f2bf(f[i] * wk); } }
        __syncthreads();
#pragma unroll
        for (int ks = 0; ks < 4; ++ks) { if (ks * 2 <= tt) { const bf16x8 sf = *(const LAS bf16x8*)(Qs + trow * LDS2 + ks * 32 + fq * 8);
#pragma unroll
                for (int nt = 0; nt < NT; ++nt) { const bf16x8 vf = *(const LAS bf16x8*)(Vt + (16 * nt + fr) * LDS2 + ks * 32 + fq * 8); accO[nt] = mfma16(vf, sf, accO[nt]); } } }
        { float inv = 1.0f;
          if (IS_ML) { const float den = __shfl(accO[NT - 1][0], fr); inv = 1.0f / fmaxf(fabsf(den), oscale[trow]); }
          const int row = dir ? rowbase + 127 - trow : rowbase + trow;
          bf16_t* op = OUT + ((size_t)(h * 4 + sl) * MT_ROWS + row) * 48 + fq * 4;
#pragma unroll
          for (int nt = 0; nt < 3; ++nt) { u32x2 w; w.x = cvt_pk_bf16(accO[nt][0] * inv, accO[nt][1] * inv); w.y = cvt_pk_bf16(accO[nt][2] * inv, accO[nt][3] * inv); *(u32x2*)(op + nt * 16) = w; } }
        if (wid < 2 * NT) { const int et = wid % NT, grp = wid / NT;
            bf16x8 vf4[4];
#pragma unroll
            for (int ks = 0; ks < 4; ++ks) vf4[ks] = *(const LAS bf16x8*)(Vt + (16 * et + fr) * LDS2 + ks * 32 + fq * 8);
            bf16x8 kw[2][4];
#pragma unroll
            for (int ks = 0; ks < 4; ++ks) kw[0][ks] = *(const LAS bf16x8*)(Ks + (16 * (grp * DPG) + fr) * LDS2 + ks * 32 + fq * 8);
#pragma unroll
            for (int dt = 0; dt < DPG; ++dt) { const int dtile = grp * DPG + dt; accC[dt] *= decay;
                if (dt + 1 < DPG) {
#pragma unroll
                    for (int ks = 0; ks < 4; ++ks) kw[(dt + 1) & 1][ks] = *(const LAS bf16x8*)(Ks + (16 * (dtile + 1) + fr) * LDS2 + ks * 32 + fq * 8); }
#pragma unroll
                for (int ks = 0; ks < 4; ++ks) accC[dt] = mfma16(kw[dt & 1][ks], vf4[ks], accC[dt]);
                u32x2 w; w.x = cvt_pk_bf16(accC[dt][0], accC[dt][1]); w.y = cvt_pk_bf16(accC[dt][2], accC[dt][3]);
                *(LAS u32x2*)(Ct + (16 * et + fr) * LDC + 16 * dtile + fq * 4) = w; } }
        __syncthreads();
    }
}

template <int LS>
__device__ __forceinline__ void hyena_item(const Params& p, int l, int b, int cg, int tb, bool isctx, LAS unsigned char* lds) {
    const int tid_ = opaque_tid();
    const int lane = tid_ & 63, wid = __builtin_amdgcn_readfirstlane(tid_ >> 6); unsigned char* ws = p.ws;
    LAS float* zs = (LAS float*)lds;
    LAS float* fs = zs + 64 * 64;
    const int ch = cg * 64 + lane; const int seg_lo = isctx ? (ML_ROWS + b * LC) : b * SEQ;
    const bf16_t* Pb = (const bf16_t*)(ws + WS_PH) + (size_t)seg_lo * NINP + cg * 64;
    bf16_t* Yb = (bf16_t*)(ws + WS_ACT) + (size_t)seg_lo * D + cg * 64;
    const float* FX = (isctx ? (const float*)(ws + WS_FC) : (const float*)(ws + WS_FX) + (size_t)l * 4096 * 512) + cg * 64;
    const float* NP = isctx ? (const float*)(ws + WS_NORM) + 16 * 512 : (const float*)(ws + WS_NORM) + (size_t)l * 8 * 512;
    const float* cw = p.in[I_HYCW] + (size_t)l * 3 * 1536;
    const float wx0a = cw[C_X0 + ch], wx0b = cw[1536 + C_X0 + ch], wx0c = cw[3072 + C_X0 + ch];
    const float wx1a = cw[C_X1 + ch], wx1b = cw[1536 + C_X1 + ch], wx1c = cw[3072 + C_X1 + ch];
    const float wva = cw[C_HV + ch], wvb = cw[1536 + C_HV + ch], wvc = cw[3072 + C_HV + ch];
    const int tblk = tb * 256, t0 = tblk + wid * 32;
    float acc[32];
#pragma unroll
    for (int i = 0; i < 32; ++i) acc[i] = 0.f;
    for (int sc = 0; sc < LS; sc += 64) {
        __syncthreads();
        { const int s8 = sc + wid * 8; const bf16_t* ps = Pb + (size_t)s8 * NINP;
          float pv0 = (s8 > 0) ? bf2f(ps[-NINP + C_HV + lane]) : 0.f, px0 = (s8 > 0) ? bf2f(ps[-NINP + C_X1 + lane]) : 0.f;
          float pv1 = bf2f(ps[C_HV + lane]), px1 = bf2f(ps[C_X1 + lane]);
#pragma unroll
          for (int k = 0; k < 8; ++k) { float pv2 = 0.f, px2 = 0.f;
              if (s8 + k + 1 < LS) { pv2 = bf2f(ps[(k + 1) * NINP + C_HV + lane]); px2 = bf2f(ps[(k + 1) * NINP + C_X1 + lane]); }
              zs[(wid * 8 + k) * 64 + lane] = (wva * pv0 + wvb * pv1 + wvc * pv2) * (wx1a * px0 + wx1b * px1 + wx1c * px2);
              pv0 = pv1; pv1 = pv2; px0 = px1; px1 = px2; } }
        { const int jlo = tblk - sc - 63 + LS - 1;
#pragma unroll 8
          for (int r = wid; r < 319; r += 8) { const int j = jlo + r; fs[r * 64 + lane] = (j >= 0 && j <= 2 * LS - 2) ? FX[(size_t)j * 512 + lane] : 0.f; } }
        __syncthreads();
#pragma unroll 1
        for (int kb = 0; kb < 4; ++kb) {
            float z[16], f[47];
            const int rb = wid * 32 + 48 - kb * 16;
#pragma unroll
            for (int k = 0; k < 16; ++k) z[k] = zs[(kb * 16 + k) * 64 + lane];
#pragma unroll
            for (int i = 0; i < 47; ++i) f[i] = fs[(rb + i) * 64 + lane];
#pragma unroll
            for (int k = 0; k < 16; ++k) {
#pragma unroll
                for (int i = 0; i < 32; ++i) acc[i] += f[15 + i - k] * z[k]; }
        }
    }
    float nsum = 0.f;
    if (isctx) nsum = NP[ch]; else {
#pragma unroll
        for (int q = 0; q < 8; ++q) nsum += NP[q * 512 + ch]; }
    const float inv = 1.0f / nsum; const float bias = p.in[I_HBIAS][l * 512 + ch];
    { const bf16_t* pt = Pb + (size_t)t0 * NINP;
      float m0 = 0.f, m1 = 0.f, m2 = 0.f;
      if (t0 > 0) { m0 = bf2f(pt[-NINP + C_X0 + lane]); m1 = bf2f(pt[-NINP + C_X1 + lane]); m2 = bf2f(pt[-NINP + C_HV + lane]); }
      float a0 = bf2f(pt[C_X0 + lane]), a1 = bf2f(pt[C_X1 + lane]), a2 = bf2f(pt[C_HV + lane]);
#pragma unroll
      for (int i = 0; i < 32; ++i) { float q0 = 0.f, q1 = 0.f, q2 = 0.f;
          if (t0 + i + 1 < LS) { q0 = bf2f(pt[(i + 1) * NINP + C_X0 + lane]); q1 = bf2f(pt[(i + 1) * NINP + C_X1 + lane]); q2 = bf2f(pt[(i + 1) * NINP + C_HV + lane]); }
          const float x0 = wx0a * m0 + wx0b * a0 + wx0c * q0; const float x1 = wx1a * m1 + wx1b * a1 + wx1c * q1; const float vv = wva * m2 + wvb * a2 + wvc * q2;
          const float zt = vv * x1; const float y = (acc[i] * inv + bias * zt) * x0;
          Yb[(size_t)(t0 + i) * D + lane] = f2bf(y);
          m0 = a0; m1 = a1; m2 = a2; a0 = q0; a1 = q1; a2 = q2;
          if ((i & 7) == 7) asm volatile("" ::: "memory"); } }
}

__device__ __forceinline__ void hyena_mfma(const Params& p, int l, int item, LAS unsigned char* lds) {
    constexpr int ZLD = 2056, GLD = 4104;
    const int tid = opaque_tid(); const int lane = tid & 63, wid = __builtin_amdgcn_readfirstlane(tid >> 6), r = lane & 15, q = lane >> 4;
    unsigned char* ws = p.ws;
    LAS bf16_t* ZS = (LAS bf16_t*)lds;
    LAS bf16_t* GS = ZS + 2 * 8 * ZLD;
    const int c0 = item * 2;
    const bf16_t* P = (const bf16_t*)(ws + WS_PH); bf16_t* Y = (bf16_t*)(ws + WS_ACT);
    const float* FX = (const float*)(ws + WS_FX) + (size_t)l * 4096 * 512;
    const float* NP = (const float*)(ws + WS_NORM) + (size_t)l * 8 * 512;
    const float* cw = p.in[I_HYCW] + (size_t)l * 3 * 1536;
    __syncthreads();
    { const int b = tid >> 6, s0 = (tid & 63) * 32;
      float wv[2][3], wx[2][3];
#pragma unroll
      for (int c = 0; c < 2; ++c)
#pragma unroll
          for (int t = 0; t < 3; ++t) { wv[c][t] = cw[t * 1536 + C_HV + c0 + c]; wx[c][t] = cw[t * 1536 + C_X1 + c0 + c]; }
      const bf16_t* pb = P + (size_t)(b * SEQ) * NINP + c0;
      unsigned vr[34], xr_[34];
#pragma unroll
      for (int k = 0; k < 34; ++k) { const int s = s0 - 1 + k; const bool ok = (s >= 0) && (s < SEQ);
          vr[k] = ok ? *(const unsigned*)(pb + (size_t)s * NINP + C_HV) : 0u; xr_[k] = ok ? *(const unsigned*)(pb + (size_t)s * NINP + C_X1) : 0u; }
#pragma unroll
      for (int g = 0; g < 4; ++g) { float za[8], zb[8];
#pragma unroll
          for (int k = 0; k < 8; ++k) { const int i = g * 8 + k; const unsigned v0 = vr[i], v1 = vr[i + 1], v2 = vr[i + 2], x0 = xr_[i], x1 = xr_[i + 1], x2 = xr_[i + 2];
              za[k] = (wv[0][0] * bf_lo(v0) + wv[0][1] * bf_lo(v1) + wv[0][2] * bf_lo(v2)) * (wx[0][0] * bf_lo(x0) + wx[0][1] * bf_lo(x1) + wx[0][2] * bf_lo(x2));
              zb[k] = (wv[1][0] * bf_hi(v0) + wv[1][1] * bf_hi(v1) + wv[1][2] * bf_hi(v2)) * (wx[1][0] * bf_hi(x0) + wx[1][1] * bf_hi(x1) + wx[1][2] * bf_hi(x2)); }
          *(LAS u32x4*)(ZS + (0 * 8 + b) * ZLD + s0 + g * 8) = pack8(za);
          *(LAS u32x4*)(ZS + (1 * 8 + b) * ZLD + s0 + g * 8) = pack8(zb); } }
    f32x4 acc[16];
    const int t0 = wid * 256;
#pragma unroll 1
    for (int c = 0; c < 2; ++c) {
        const int ch = c0 + c;
        __syncthreads();
        { float nsum = 0.f;
#pragma unroll
          for (int qq = 0; qq < 8; ++qq) nsum += NP[qq * 512 + ch];
          const float inv = 1.0f / nsum; const float bias = p.in[I_HBIAS][l * 512 + ch];
#pragma unroll
          for (int i = 0; i < 8; ++i) { const int m = tid + i * 512; float g = 0.f;
              if (m <= 4094) { g = FX[(size_t)(4094 - m) * 512 + ch] * inv; if (m == 2047) g += bias; }
              const bf16_t gb = f2bf(g);
#pragma unroll
              for (int k = 0; k < 8; ++k) { if (m - k >= 0) GS[k * GLD + (m - k)] = gb; } }
        }
        __syncthreads();
        const int kc = (7 - r) & 7;
        const LAS bf16_t* gp = GS + kc * GLD + (2047 - t0 - r + 8 * q - kc);
        const LAS bf16_t* zp = ZS + (c * 8 + (lane & 7)) * ZLD + 8 * q;
        bf16x8 ring[16];
#pragma unroll
        for (int i = 0; i < 16; ++i) { acc[i] = (f32x4){0.f, 0.f, 0.f, 0.f}; ring[i] = *(const LAS bf16x8*)(gp - 16 * i); }
        bf16x8 zf = *(const LAS bf16x8*)zp;
#pragma unroll 1
        for (int J = 0; J < 8; ++J) {
#pragma unroll
            for (int jj = 0; jj < 8; ++jj) { const int j = J * 8 + jj;
                bf16x8 rn0 = zf, rn1 = zf, zn = zf;
                if (j + 1 < 64) { rn0 = *(const LAS bf16x8*)(gp + 16 * (2 * (j + 1))); rn1 = *(const LAS bf16x8*)(gp + 16 * (2 * (j + 1) - 1)); zn = *(const LAS bf16x8*)(zp + 32 * (j + 1)); }
#pragma unroll
                for (int i = 0; i < 16; ++i) acc[i] = mfma16(ring[(i - 2 * jj) & 15], zf, acc[i]);
                if (j + 1 < 64) { ring[(16 - 2 * (jj + 1)) & 15] = rn0; ring[(17 - 2 * (jj + 1)) & 15] = rn1; }
                zf = zn; } }
        __syncthreads();
        if (r < 8) { LAS bf16_t* yb_ = ZS + (c * 8 + r) * ZLD + t0 + 4 * q;
#pragma unroll
            for (int i = 0; i < 16; ++i) { u32x2 w; w.x = cvt_pk_bf16(acc[i][0], acc[i][1]); w.y = cvt_pk_bf16(acc[i][2], acc[i][3]); *(LAS u32x2*)(yb_ + 16 * i) = w; } }
    }
    __syncthreads();
    { const int b = tid >> 6;
      float w0[3], w1[3];
#pragma unroll
      for (int t = 0; t < 3; ++t) { w0[t] = cw[t * 1536 + C_X0 + c0]; w1[t] = cw[t * 1536 + C_X0 + c0 + 1]; }
      const bf16_t* pb = P + (size_t)(b * SEQ) * NINP + C_X0 + c0; bf16_t* yb = Y + (size_t)(b * SEQ) * D + c0;
      unsigned xall[8][6];
#pragma unroll
      for (int k = 0; k < 8; ++k) { const int tb = 4 * (tid & 63) + 256 * k;
#pragma unroll
          for (int u = 0; u < 6; ++u) { const int t = tb - 1 + u; xall[k][u] = (t >= 0 && t < SEQ) ? *(const unsigned*)(pb + (size_t)t * NINP) : 0u; } }
#pragma unroll
      for (int k = 0; k < 8; ++k) { const int tb = 4 * (tid & 63) + 256 * k;
          const unsigned* xr = xall[k];
          const u32x2 ya = *(const LAS u32x2*)(ZS + (0 * 8 + b) * ZLD + tb), yc = *(const LAS u32x2*)(ZS + (1 * 8 + b) * ZLD + tb);
          const float y0[4] = {bf_lo(ya.x), bf_hi(ya.x), bf_lo(ya.y), bf_hi(ya.y)}, y1[4] = {bf_lo(yc.x), bf_hi(yc.x), bf_lo(yc.y), bf_hi(yc.y)};
#pragma unroll
          for (int jj = 0; jj < 4; ++jj) {
              const float xa = w0[0] * bf_lo(xr[jj]) + w0[1] * bf_lo(xr[jj + 1]) + w0[2] * bf_lo(xr[jj + 2]);
              const float xb = w1[0] * bf_hi(xr[jj]) + w1[1] * bf_hi(xr[jj + 1]) + w1[2] * bf_hi(xr[jj + 2]);
              *(unsigned*)(yb + (size_t)(tb + jj) * D) = cvt_pk_bf16(y0[jj] * xa, y1[jj] * xb); } } }
    __syncthreads();
}

__device__ __forceinline__ void phase_mixers(const Params& p, int l, LAS unsigned char* lds) {
    const int G = gridDim.x, bid = blockIdx.x;
    const int vb = (G % 8 == 0) ? (bid & 7) * (G >> 3) + (bid >> 3) : bid;
    for (int item = vb; item < 256; item += G) scan_chain<192, 4, true>(p, l, item, lds);
    for (int item = vb; item < 256; item += G) scan_chain<96, 3, false>(p, l, item, lds);
    for (int item = vb; item < 256; item += G) hyena_mfma(p, l, item, lds);
    if (l == 0) { for (int item = G - 1 - bid; item < 64; item += G) hyena_item<LC>(p, l, item >> 3, item & 7, 0, true, lds); }
}

__device__ __forceinline__ void phase_combine(const Params& p, int l, int nrows) {
    const int tidq = opaque_tid(); unsigned char* ws = p.ws; const int lane = tidq & 63; const int gw = blockIdx.x * 8 + (tidq >> 6), nw = gridDim.x * 8;
    const bf16_t* P = (const bf16_t*)(ws + WS_PH); bf16_t* Y = (bf16_t*)(ws + WS_ACT);
    const float* ng = p.in[I_MLNG] + (size_t)l * 768;
    const int li = lane & 31, e0 = 6 * li, sl = li >> 3, ee = 6 * (li & 7);
    const int vbq = (gridDim.x % 8 == 0) ? (blockIdx.x & 7) * (gridDim.x >> 3) + (blockIdx.x >> 3) : blockIdx.x; const int per = (nrows * 4 + nw - 1) / nw; const int ubeg = (vbq * 8 + (tidq >> 6)) * per;
    for (int u = ubeg; u < ubeg + per && u < nrows * 4; ++u) { const int row = u >> 2, grp = (u >> 1) & 1, h = (u & 1) * 2 + (lane >> 5);
        const bf16_t* o0 = (const bf16_t*)(ws + (grp ? WS_OR : WS_OM)) + ((size_t)(h * 4 + sl) * MT_ROWS + row) * 48 + ee; const bf16_t* o1 = o0 + OMR_DIR / 2;
        const bf16_t* gp = P + (size_t)row * NINP + (grp ? C_RG : C_MLO) + h * 192 + e0;
        unsigned a[3], c[3], gt[3];
#pragma unroll
        for (int i = 0; i < 3; ++i) { a[i] = ((const unsigned*)o0)[i]; c[i] = ((const unsigned*)o1)[i]; gt[i] = ((const unsigned*)gp)[i]; }
        float v[6]; float ss = 0.f;
#pragma unroll
        for (int i = 0; i < 3; ++i) { v[2 * i] = bf_lo(a[i]) + bf_lo(c[i]); v[2 * i + 1] = bf_hi(a[i]) + bf_hi(c[i]); ss += v[2 * i] * v[2 * i] + v[2 * i + 1] * v[2 * i + 1]; }
#pragma unroll
        for (int o = 16; o > 0; o >>= 1) ss += __shfl_xor(ss, o);
        const float r = rsqrtf(ss * (1.0f / 192.0f) + EPS);
        float y[6];
#pragma unroll
        for (int i = 0; i < 6; ++i) { const float g = (i & 1) ? bf_hi(gt[i >> 1]) : bf_lo(gt[i >> 1]);
            y[i] = grp ? (v[i] * r * siluf(g)) : (v[i] * r * ng[h * 192 + e0 + i] * sigmf(g)); }
        unsigned* yp = (unsigned*)(Y + (size_t)row * D + (grp ? 1280 : 512) + h * 192 + e0);
#pragma unroll
        for (int i = 0; i < 3; ++i) yp[i] = cvt_pk_bf16(y[2 * i], y[2 * i + 1]); }
}

__device__ __forceinline__ void phase_final(const Params& p) {
    const int tidq = opaque_tid(); const int lane = tidq & 63; const int gw = blockIdx.x * 8 + (tidq >> 6), nw = gridDim.x * 8;
    const float* g = p.in[I_FING];
    const int per = (ML_ROWS + nw - 1) / nw; const int r0 = gw * per; const int r1 = (r0 + per < ML_ROWS) ? r0 + per : ML_ROWS;
    f32x4 gg[8];
#pragma unroll
    for (int i = 0; i < 8; ++i) gg[i] = *(const f32x4*)(g + i * 256 + lane * 4);
    for (int row = r0; row < r1; row += 2) { const bool two = row + 1 < r1; float* s0 = p.out + (size_t)row * D; float* s1 = p.out + (size_t)(two ? row + 1 : row) * D;
        f32x4 v0[8], v1[8]; float ss0 = 0.f, ss1 = 0.f;
#pragma unroll
        for (int i = 0; i < 8; ++i) { v0[i] = *(const f32x4*)(s0 + i * 256 + lane * 4); v1[i] = *(const f32x4*)(s1 + i * 256 + lane * 4); }
#pragma unroll
        for (int i = 0; i < 8; ++i) { ss0 += v0[i][0] * v0[i][0] + v0[i][1] * v0[i][1] + v0[i][2] * v0[i][2] + v0[i][3] * v0[i][3]; ss1 += v1[i][0] * v1[i][0] + v1[i][1] * v1[i][1] + v1[i][2] * v1[i][2] + v1[i][3] * v1[i][3]; }
        ss0 = wave_sum(ss0); ss1 = wave_sum(ss1);
        const float ra = rsqrtf(ss0 * (1.0f / D) + EPS), rb = rsqrtf(ss1 * (1.0f / D) + EPS);
#pragma unroll
        for (int i = 0; i < 8; ++i) { const int c = i * 256 + lane * 4; *(f32x4*)(s0 + c) = v0[i] * ra * gg[i]; if (two) *(f32x4*)(s1 + c) = v1[i] * rb * gg[i]; } }
}

#define XB_TMO      128
#define XB_XCNT(j)  (256  + 64 * (j))
#define XB_XSUB(j)  (1280 + 64 * (j))
#define XB_XGEN(j)  (2304 + 64 * (j))
#define XB_TOP      3328
#define XB_TOPGEN   3392
#define XCD_BAR_WORDS 3456
#define XB_SPIN_CAP (1u << 22)
__device__ __forceinline__ unsigned xb_ld(unsigned* p)              { return __hip_atomic_load(p, __ATOMIC_RELAXED, __HIP_MEMORY_SCOPE_AGENT); }
__device__ __forceinline__ unsigned xb_add(unsigned* p, unsigned v) { return __hip_atomic_fetch_add(p, v, __ATOMIC_RELAXED, __HIP_MEMORY_SCOPE_AGENT); }
__device__ __forceinline__ unsigned xb_xcc_id() { return (unsigned)__builtin_amdgcn_s_getreg((3 << 11) | 20) & 0xFu; }
#define XB_SPIN(cond, bar) do { unsigned _sp = 0; while (cond) { __builtin_amdgcn_s_sleep(1); \
    if ((++_sp & 255u) == 0u) { if (xb_ld(&(bar)[XB_TMO])) break; if (_sp > XB_SPIN_CAP) { atomicAdd(&(bar)[XB_TMO], 1u); break; } } } } while (0)
struct XcdBarrier { unsigned* bar; volatile LAS unsigned* st; };
__device__ __forceinline__ XcdBarrier xcd_barrier_post(unsigned* bar, volatile LAS unsigned* st) {
    XcdBarrier b; b.bar = bar; b.st = st; const unsigned x = (unsigned)__builtin_amdgcn_readfirstlane((int)xb_xcc_id());
    if (threadIdx.x == 0) (void)xb_add(&bar[XB_XCNT(x)], 1u);
    return b;
}
__device__ __forceinline__ void xcd_barrier_complete(unsigned* bar, unsigned x, unsigned& nloc, unsigned& nx) {
    const unsigned G = gridDim.x * gridDim.y * gridDim.z;
    unsigned sum, cnt, mine, sp = 0u;
    for (;;) {
        sum = 0u; cnt = 0u; mine = 0u;
#pragma unroll
        for (unsigned j = 0; j < 16; ++j) { const unsigned c = xb_ld(&bar[XB_XCNT(j)]); sum += c; cnt += (c > 0u) ? 1u : 0u; mine = (j == x) ? c : mine; }
        if (sum == G) break;
        __builtin_amdgcn_s_sleep(1);
        if ((++sp & 255u) == 0u) { if (xb_ld(&bar[XB_TMO])) break; if (sp > XB_SPIN_CAP) { atomicAdd(&bar[XB_TMO], 1u); break; } }
    }
    nloc = mine > 0u ? mine : 1u; nx = cnt > 0u ? cnt : 1u;
}
__device__ __forceinline__ void xcd_barrier(const XcdBarrier& b) {
    asm volatile("s_waitcnt vmcnt(0)" ::: "memory");
    __syncthreads();
    if (threadIdx.x == 0) {
        unsigned* bar = b.bar; const unsigned bx = (unsigned)__builtin_amdgcn_readfirstlane((int)xb_xcc_id());
        __builtin_amdgcn_s_waitcnt(0);
        unsigned nloc = b.st[0], nx = b.st[1];
        if (nloc == 0u) { xcd_barrier_complete(bar, bx, nloc, nx); b.st[0] = nloc; b.st[1] = nx; }
        const unsigned old = xb_add(&bar[XB_XSUB(bx)], 1u);
        const unsigned gen = old / nloc;
        if (old + 1u == (gen + 1u) * nloc) {
            __builtin_amdgcn_fence(__ATOMIC_RELEASE, "agent");
            asm volatile("s_waitcnt vmcnt(0)" ::: "memory");
            const unsigned og = xb_add(&bar[XB_TOP], 1u);
            const unsigned tg = og / nx;
            if (og + 1u == (tg + 1u) * nx) xb_add(&bar[XB_TOPGEN], 1u);
            else XB_SPIN(xb_ld(&bar[XB_TOPGEN]) == tg, bar);
            __builtin_amdgcn_fence(__ATOMIC_ACQUIRE, "agent");
            xb_add(&bar[XB_XGEN(bx)], 1u);
            asm volatile("s_waitcnt vmcnt(0)" ::: "memory");
        } else {
            XB_SPIN(xb_ld(&bar[XB_XGEN(bx)]) == gen, bar);
            __builtin_amdgcn_fence(__ATOMIC_ACQUIRE, "agent");
            asm volatile("s_waitcnt vmcnt(0)" ::: "memory");
        }
    }
    __syncthreads();
}

#ifndef WGM_IN
#define WGM_IN 8
#define WGM_OUT 4
#define WGM_FF1 8
#define WGM_FF2 4
#endif
__global__ void __launch_bounds__(NTHREADS, 2) mk_fwd(Params p) {
    extern __shared__ __attribute__((aligned(16))) unsigned char lds_raw[];
    LAS unsigned char* lds = (LAS unsigned char*)lds_raw;
    cg::grid_group grid = cg::this_grid();
    unsigned char* ws = p.ws; const int G = gridDim.x, bid = blockIdx.x;
    bf16_t* ACT = (bf16_t*)(ws + WS_ACT); bf16_t* PH = (bf16_t*)(ws + WS_PH); float* XC = (float*)(ws + WS_XC);

    volatile LAS unsigned* bst = (volatile LAS unsigned*)(lds + LDS_BYTES - 32);
    if (threadIdx.x == 0) { bst[0] = 0u; bst[1] = 0u; }
    __syncthreads();
    const XcdBarrier xb = xcd_barrier_post((unsigned*)(ws + WS_BAR), bst);
    grid.sync();
    phase_prologue(p, lds);
    xcd_barrier(xb);
#pragma nounroll
    for (int l = 0; l < 2; ++l) {
        const float* mod = (const float*)(ws + WS_MOD) + (size_t)l * 9 * 12288;
        const bf16_t* wt = (const bf16_t*)(ws + WS_WT + (size_t)l * WT_LAYER);
        const float* xin = l == 0 ? p.in[I_X] : p.out; const float* cin = l == 0 ? p.in[I_CTX] : XC;
        if (l == 0) filter_items(p, lds, G - 1 - bid, G);
        phase_norm_mod(xin, cin, p.in[I_N1G] + l * D, mod, 0, MT_ROWS, ACT);
        xcd_barrier(xb);
        { pg8::StaticOrder S; S.init(MT_ROWS, NINP, G, bid, WGM_IN); EpiBf16<0> E{PH, NINP, (float*)(ws + WS_GATE)};
          pg8::gemm_phase(lds, pg8::Gemm{ACT, wt + WT_IN_OFF / 2, MT_ROWS, NINP, D}, S, E); }
        xcd_barrier(xb);
        phase_qk(p, l);
        xcd_barrier(xb);
        phase_mixers(p, l, lds);
        xcd_barrier(xb);
        phase_combine(p, l, l == 0 ? MT_ROWS : ML_ROWS);
        xcd_barrier(xb);
        const int Mr = l == 0 ? MT_ROWS : ML_ROWS;
        { pg8::StaticOrder S; S.init(Mr, D, G, bid, WGM_OUT); EpiRes E{xin, p.out, cin, XC, mod, 2};
          pg8::gemm_phase(lds, pg8::Gemm{ACT, wt + WT_OUT_OFF / 2, Mr, D, D}, S, E); }
        xcd_barrier(xb);
        phase_norm_mod(p.out, XC, p.in[I_N2G] + l * D, mod, 3, Mr, ACT);
        xcd_barrier(xb);
        { pg8::StaticOrder S; S.init(Mr, DFF, G, bid, WGM_FF1); EpiBf16<1> E{PH, DFF, nullptr};
          pg8::gemm_phase(lds, pg8::Gemm{ACT, wt + WT_FF1_OFF / 2, Mr, DFF, D}, S, E); }
        xcd_barrier(xb);
        { pg8::StaticOrder S; S.init(Mr, D, G, bid, WGM_FF2); EpiRes E{p.out, p.out, XC, XC, mod, 5};
          pg8::gemm_phase(lds, pg8::Gemm{PH, wt + WT_FF2_OFF / 2, Mr, D, DFF}, S, E); }
        xcd_barrier(xb);
    }
    phase_final(p);
}

extern "C" void kernel_launch(void* const* d_in, const int* in_sizes, int n_in, void* d_out, int out_size, void* d_ws, size_t ws_size, hipStream_t stream) {
    static int grid = 0;
    if (!grid) {
        int dev = 0, cus = 0, per_cu = 0;
        (void)hipGetDevice(&dev);
        (void)hipDeviceGetAttribute(&cus, hipDeviceAttributeMultiprocessorCount, dev);
        (void)hipFuncSetAttribute((const void*)mk_fwd, hipFuncAttributeMaxDynamicSharedMemorySize, LDS_BYTES);
        (void)hipOccupancyMaxActiveBlocksPerMultiprocessor(&per_cu, (const void*)mk_fwd, NTHREADS, LDS_BYTES);
        if (per_cu < 1) per_cu = 1;
        grid = cus * per_cu;
        if (ws_size < WS_END || n_in != 25) { fprintf(stderr, "kernel_launch: workspace %zu < %zu or n_in %d != 25\n", ws_size, (size_t)WS_END, n_in); }
    }
    (void)hipMemsetAsync((unsigned char*)d_ws + WS_BAR, 0, 16384, stream);
    Params p{};
    for (int i = 0; i < 25; ++i) p.in[i] = (const float*)d_in[i];
    p.out = (float*)d_out; p.ws = (unsigned char*)d_ws;
    void* args[] = {&p};
    hipError_t e = hipLaunchCooperativeKernel((const void*)mk_fwd, dim3(grid), dim3(NTHREADS), args, LDS_BYTES, stream);
    if (e != hipSuccess) fprintf(stderr, "cooperative launch failed: %s (grid %d)\n", hipGetErrorString(e), grid);
}
```

```cpp
#include <hip/hip_runtime.h>
#include <hip/hip_cooperative_groups.h>
#include <cstdio>
namespace cg = cooperative_groups;

#define LAS __attribute__((address_space(3)))
typedef unsigned short bf16_t;
typedef short bf16x8 __attribute__((ext_vector_type(8)));
typedef float f32x4 __attribute__((ext_vector_type(4)));
typedef unsigned u32x4 __attribute__((ext_vector_type(4)));
typedef unsigned u32x2 __attribute__((ext_vector_type(2)));

constexpr int D = 2048, NB = 8, SEQ = 2048, LC = 256;
constexpr int ML_ROWS = NB * SEQ;
constexpr int MC_ROWS = NB * LC;
constexpr int MT_ROWS = ML_ROWS + MC_ROWS;
constexpr int NIN = 6928, NINP = 7168, DFF = 8192;
constexpr int C_X0 = 0, C_X1 = 512, C_HV = 1024;
constexpr int C_MLQ = 1536, C_MLK = 2304, C_MLV = 3072, C_MLO = 3840, C_G = 4608;
constexpr int C_RQ = 4624, C_RK = 5008, C_RV = 5392, C_RG = 6160;
constexpr float EPS = 1e-6f;
constexpr int NTHREADS = 512;
constexpr int LDS_BYTES = 155648;

constexpr size_t WT_LAYER = 104857600ull;
constexpr size_t WT_IN_OFF = 0, WT_OUT_OFF = 29360128ull, WT_FF1_OFF = 37748736ull, WT_FF2_OFF = 71303168ull;
constexpr size_t WS_WT = 0;
constexpr size_t WS_ACT = 209715200ull;
constexpr size_t WS_PH = WS_ACT + 75497472ull;
constexpr size_t WS_XC = WS_PH + 301989888ull;
constexpr size_t WS_OM = WS_XC + 16777216ull;
constexpr size_t OMR_DIR = (size_t)MT_ROWS * 768 * 2;
constexpr size_t WS_OR = WS_OM + 2 * OMR_DIR;
constexpr size_t WS_FX = WS_OR + 2 * OMR_DIR;
constexpr size_t WS_FC = WS_FX + 16777216ull;
constexpr size_t WS_HD = WS_FC + 1048576ull;
constexpr size_t WS_MOD = WS_HD + 1114112ull;
constexpr size_t WS_GATE = WS_MOD + 884736ull;
constexpr size_t WS_ROPE = WS_GATE + 1179648ull;
constexpr size_t WS_NORM = WS_ROPE + 786432ull;
constexpr size_t WS_CTR = WS_NORM + 34816ull;
constexpr size_t WS_BAR = WS_CTR + 256ull;
constexpr size_t WS_END = WS_BAR + 16384ull;

struct Params { const float* in[25]; float* out; unsigned char* ws; };
enum { I_X = 0, I_C, I_CTX, I_CCTX, I_N1G, I_N2G, I_WMOD, I_BMOD, I_WIN, I_HYCW, I_HW1, I_HB1, I_HW2, I_HB2, I_HW3, I_HFREQ, I_HBIAS,
       I_MLCW, I_MLGB, I_MLNG, I_RTLD, I_WOUT, I_WFF1, I_WFF2, I_FING };

typedef float f32x2_t __attribute__((ext_vector_type(2)));
typedef __bf16 bf16x2_t __attribute__((ext_vector_type(2)));
__device__ __forceinline__ unsigned cvt_pk_bf16(float lo, float hi) { f32x2_t v = {lo, hi}; bf16x2_t b = __builtin_convertvector(v, bf16x2_t); return __builtin_bit_cast(unsigned, b); }
__device__ __forceinline__ float bf_lo(unsigned u) { return __uint_as_float(u << 16); }
__device__ __forceinline__ float bf_hi(unsigned u) { return __uint_as_float(u & 0xFFFF0000u); }
__device__ __forceinline__ float bf2f(bf16_t b) { return __uint_as_float(((unsigned)b) << 16); }
__device__ __forceinline__ bf16_t f2bf(float f) { return (bf16_t)(cvt_pk_bf16(f, 0.f) & 0xFFFFu); }
__device__ __forceinline__ float siluf(float x) { return x * __builtin_amdgcn_rcpf(1.0f + __expf(-x)); }
__device__ __forceinline__ float sigmf(float x) { return __builtin_amdgcn_rcpf(1.0f + __expf(-x)); }
__device__ __forceinline__ int opaque_tid() { int t = threadIdx.x; asm volatile("" : "+v"(t)); return t; }
__device__ __forceinline__ float wave_sum(float v) {
#pragma unroll
    for (int o = 32; o > 0; o >>= 1) v += __shfl_xor(v, o);
    return v;
}
__device__ __forceinline__ void unpack8(const u32x4 v, float (&f)[8]) {
    f[0] = bf_lo(v.x); f[1] = bf_hi(v.x); f[2] = bf_lo(v.y); f[3] = bf_hi(v.y); f[4] = bf_lo(v.z); f[5] = bf_hi(v.z); f[6] = bf_lo(v.w); f[7] = bf_hi(v.w);
}
__device__ __forceinline__ u32x4 pack8(const float (&f)[8]) {
    u32x4 w; w.x = cvt_pk_bf16(f[0], f[1]); w.y = cvt_pk_bf16(f[2], f[3]); w.z = cvt_pk_bf16(f[4], f[5]); w.w = cvt_pk_bf16(f[6], f[7]); return w;
}

namespace pg8 {
constexpr int BM = 256, BK = 64, HALF = 128, HTB = HALF * BK * 2, STAGE_BYTES = 8 * HTB, NXCD = 8, WGM = 4;
__host__ __device__ __forceinline__ int lds_byte(int r, int c) { const int st = (r >> 4) * 2 + (c >> 5), rr = r & 15, cc = c & 31, ob = rr * 64 + cc * 2; return st * 1024 + (ob ^ (((ob >> 9) & 1) << 5)); }
__host__ __device__ __forceinline__ void stage_rc(int b, int& R, int& C) { const int st = b / 1024, sb = b % 1024, swz = sb ^ (((sb >> 9) & 1) << 5); R = (st >> 1) * 16 + swz / 64; C = (st & 1) * 32 + (swz % 64) / 2; }
__host__ __device__ __forceinline__ int perm32(int rho) { const int n = rho >> 4, i = rho & 15; return 8 * (i >> 2) + 4 * n + (i & 3); }
struct Unit { int pm, pn; };
struct Gemm { const bf16_t* A; const bf16_t* Bt; int M, N, K; };
struct StaticOrder {
    int nM, nN, nwg, G, c, wgm;
    __host__ __device__ void init(int M, int N, int G_, int c_, int wgm_ = WGM) { nM = M / BM; nN = N / BM; nwg = nM * nN; G = G_; c = c_; wgm = wgm_; }
    __host__ __device__ bool next(int i, Unit& u) const {
        const long L = (long)i * G + c; if (L >= nwg) return false;
        int wgid = (int)L; { const int q = nwg / NXCD, r = nwg % NXCD, xcd = wgid % NXCD, off = wgid / NXCD; wgid = (xcd < r ? xcd * (q + 1) : r * (q + 1) + (xcd - r) * q) + off; }
        const int nig = wgm * nN, gid = wgid / nig, fm = gid * wgm, gsz = (nM - fm) < wgm ? (nM - fm) : wgm;
        u.pm = fm + ((wgid % nig) % gsz); u.pn = (wgid % nig) / gsz; return true;
    }
    __device__ __forceinline__ void a_ready(const Unit&) const {}
    __device__ __forceinline__ void done(const Unit&) const {}
};

template <class Epi, class Sched>
__device__ __forceinline__ void gemm_phase(LAS unsigned char* lds, const Gemm g, const Sched& S, const Epi& E) {
    int tid_ = threadIdx.x; asm volatile("" : "+v"(tid_));
    const int tid = tid_, wid = __builtin_amdgcn_readfirstlane(tid >> 6), lane = tid & 63, wr = wid >> 2, wc = wid & 3, fr = lane & 15, fq = lane >> 4;
    const int K = g.K, nt = K / BK;
    unsigned voffA[2], voffB[2];
#pragma unroll
    for (int i = 0; i < 2; ++i) { int R, C; stage_rc(tid * 16 + i * 8192, R, C); const int Rb = Epi::PERM ? ((R & ~31) + perm32(R & 31)) : R;
        voffA[i] = (unsigned)(R * K + C) * 2u; voffB[i] = (unsigned)(Rb * K + C) * 2u; }
    const size_t kstep = (size_t)(BK * 2);
    const size_t hstep = (size_t)HALF * K * 2;
    const size_t tstep = 2 * hstep;
    const unsigned ldsw = (unsigned)wid * 1024u;
    const int aoff = lds_byte(wr * 64 + fr, fq * 8), boff = lds_byte(wc * 32 + fr, fq * 8);
#define PG8_SA(b, h) (((b) * 2 + (h)) * HTB)
#define PG8_SB(b, h) ((4 + (b) * 2 + (h)) * HTB)
#define PG8_STAGE(bufoff, gbase, voff) do { _Pragma("unroll") for (int _i = 0; _i < 2; ++_i) \
        __builtin_amdgcn_global_load_lds((const unsigned*)((const char*)(gbase) + (voff)[_i]), (LAS unsigned*)(lds + (bufoff) + ldsw + _i * 8192), 16, 0, 0); } while (0)
#define PG8_LDA(dst, b, h) do { _Pragma("unroll") for (int m = 0; m < 4; ++m) _Pragma("unroll") for (int k = 0; k < 2; ++k) dst[m][k] = *(const LAS bf16x8*)(lds + PG8_SA(b, h) + aoff + m * 2048 + k * 1024); } while (0)
#define PG8_LDB(dst, b, h) do { _Pragma("unroll") for (int n = 0; n < 2; ++n) _Pragma("unroll") for (int k = 0; k < 2; ++k) dst[n][k] = *(const LAS bf16x8*)(lds + PG8_SB(b, h) + boff + n * 2048 + k * 1024); } while (0)
#define PG8_MMA(ai, bj, At, Bt) do { __builtin_amdgcn_s_setprio(1); _Pragma("unroll") for (int m = 0; m < 4; ++m) _Pragma("unroll") for (int n = 0; n < 2; ++n) _Pragma("unroll") for (int k = 0; k < 2; ++k) \
        acc[ai][bj][m][n] = __builtin_amdgcn_mfma_f32_16x16x32_bf16(Bt[n][k], At[m][k], acc[ai][bj][m][n], 0, 0, 0); __builtin_amdgcn_s_setprio(0); } while (0)
#define PG8_WAIT_V(n) asm volatile("s_waitcnt vmcnt(" #n ")" ::: "memory")
#define PG8_WAIT_L(n) asm volatile("s_waitcnt lgkmcnt(" #n ")" ::: "memory")
#define PG8_BAR __builtin_amdgcn_s_barrier()
#define PG8_SCHED __builtin_amdgcn_sched_barrier(0)
    Unit cur, nxt; int ui = 0;
    if (!S.next(0, cur)) return;
    f32x4 acc[2][2][4][2];
#pragma unroll
    for (int a = 0; a < 2; ++a)
#pragma unroll
        for (int b = 0; b < 2; ++b)
#pragma unroll
            for (int m = 0; m < 4; ++m)
#pragma unroll
                for (int n = 0; n < 2; ++n) acc[a][b][m][n] = (f32x4){0.f, 0.f, 0.f, 0.f};
    bf16x8 At[4][2], B0[2][2], B1[2][2];
    const char* cA = (const char*)g.A + (size_t)cur.pm * tstep; const char* cB = (const char*)g.Bt + (size_t)cur.pn * tstep;
    S.a_ready(cur);
    PG8_STAGE(PG8_SB(0, 0), cB, voffB); PG8_STAGE(PG8_SA(0, 0), cA, voffA); PG8_STAGE(PG8_SB(0, 1), cB + hstep, voffB); PG8_STAGE(PG8_SA(0, 1), cA + hstep, voffA);
    if (wr == 1) PG8_BAR;
    PG8_WAIT_V(4); PG8_BAR;
    PG8_STAGE(PG8_SB(1, 0), cB + kstep, voffB); PG8_STAGE(PG8_SA(1, 0), cA + kstep, voffA); PG8_STAGE(PG8_SB(1, 1), cB + hstep + kstep, voffB);
    PG8_WAIT_V(6); PG8_BAR;
    for (;;) {
        const bool has_next = S.next(ui + 1, nxt);
        const char* nA = has_next ? (const char*)g.A + (size_t)nxt.pm * tstep : cA; const char* nB = has_next ? (const char*)g.Bt + (size_t)nxt.pn * tstep : cB;
        for (int t = 0; t < nt; t += 2) {
            const bool last = (t == nt - 2);
            const char* a1 = cA + (size_t)(t + 1) * kstep;
            const char* a2 = last ? nA : cA + (size_t)(t + 2) * kstep; const char* b2 = last ? nB : cB + (size_t)(t + 2) * kstep;
            const char* a3 = a2 + kstep; const char* b3 = b2 + kstep;
            if (last && has_next) S.a_ready(nxt);
            PG8_LDB(B0, 0, 0); PG8_SCHED; PG8_LDA(At, 0, 0); PG8_STAGE(PG8_SA(1, 1), a1 + hstep, voffA);
            PG8_WAIT_L(8); PG8_BAR; PG8_WAIT_L(0); PG8_MMA(0, 0, At, B0); PG8_BAR; PG8_SCHED;
            PG8_LDB(B1, 0, 1); PG8_STAGE(PG8_SB(0, 0), b2, voffB);
            PG8_BAR; PG8_WAIT_L(0); PG8_MMA(0, 1, At, B1); PG8_BAR;
            PG8_LDA(At, 0, 1); PG8_STAGE(PG8_SA(0, 0), a2, voffA);
            PG8_BAR; PG8_WAIT_L(0); PG8_MMA(1, 0, At, B0); PG8_BAR; PG8_SCHED;
            PG8_STAGE(PG8_SB(0, 1), b2 + hstep, voffB);
            PG8_WAIT_V(6); PG8_BAR; PG8_MMA(1, 1, At, B1); PG8_BAR;
            PG8_LDB(B0, 1, 0); PG8_SCHED; PG8_LDA(At, 1, 0); PG8_STAGE(PG8_SA(0, 1), a2 + hstep, voffA);
            PG8_WAIT_L(8); PG8_BAR; PG8_WAIT_L(0); PG8_MMA(0, 0, At, B0); PG8_BAR; PG8_SCHED;
            PG8_LDB(B1, 1, 1); PG8_STAGE(PG8_SB(1, 0), b3, voffB);
            PG8_BAR; PG8_WAIT_L(0); PG8_MMA(0, 1, At, B1); PG8_BAR;
            PG8_LDA(At, 1, 1); PG8_STAGE(PG8_SA(1, 0), a3, voffA);
            PG8_BAR; PG8_WAIT_L(0); PG8_MMA(1, 0, At, B0); PG8_BAR; PG8_SCHED;
            PG8_STAGE(PG8_SB(1, 1), b3 + hstep, voffB);
            PG8_WAIT_V(6); PG8_BAR; PG8_MMA(1, 1, At, B1); PG8_BAR;
        }
        E(acc, cur, wr, wc, fr, fq); S.done(cur);
        if (!has_next) break;
#pragma unroll
        for (int a = 0; a < 2; ++a)
#pragma unroll
            for (int b = 0; b < 2; ++b)
#pragma unroll
                for (int m = 0; m < 4; ++m)
#pragma unroll
                    for (int n = 0; n < 2; ++n) acc[a][b][m][n] = (f32x4){0.f, 0.f, 0.f, 0.f};
        cur = nxt; cA = nA; cB = nB; ++ui;
    }
    PG8_WAIT_V(0);
    if (wr == 0) PG8_BAR;
    PG8_BAR;
#undef PG8_SA
#undef PG8_SB
#undef PG8_STAGE
#undef PG8_LDA
#undef PG8_LDB
#undef PG8_MMA
#undef PG8_WAIT_V
#undef PG8_WAIT_L
#undef PG8_BAR
#undef PG8_SCHED
}
}

template <int ACT  > struct EpiBf16 {
    static constexpr bool PERM = true;
    bf16_t* O; int ldc; float* gate;
    __device__ __forceinline__ void operator()(const f32x4 (&acc)[2][2][4][2], const pg8::Unit& u, int wr, int wc, int fr, int fq) const {
        const int row0 = u.pm * 256 + wr * 64 + fr; const int col0 = u.pn * 256 + wc * 32 + 8 * fq;
#pragma unroll
        for (int ai = 0; ai < 2; ++ai)
#pragma unroll
            for (int m = 0; m < 4; ++m) { const int row = row0 + ai * 128 + m * 16; bf16_t* rowp = O + (size_t)row * ldc + col0;
#pragma unroll
                for (int bj = 0; bj < 2; ++bj) { f32x4 v0 = acc[ai][bj][m][0], v1 = acc[ai][bj][m][1];
                    if (ACT == 1) {
#pragma unroll
                        for (int j = 0; j < 4; ++j) { float a = fmaxf(v0[j], 0.f), b = fmaxf(v1[j], 0.f); v0[j] = a * a; v1[j] = b * b; } }
                    if (ACT == 0) { if (u.pn == (C_G / 256) && bj == 0 && wc == 0 && fq < 2) { float* gp = gate + (size_t)row * 16 + 8 * fq; *(f32x4*)gp = v0; *(f32x4*)(gp + 4) = v1; } }
                    u32x4 w; w.x = cvt_pk_bf16(v0[0], v0[1]); w.y = cvt_pk_bf16(v0[2], v0[3]); w.z = cvt_pk_bf16(v1[0], v1[1]); w.w = cvt_pk_bf16(v1[2], v1[3]);
                    *(u32x4*)(rowp + bj * 128) = w; } }
    }
};
struct EpiRes {
    static constexpr bool PERM = false;
    const float* xi; float* xo; const float* ci; float* co; const float* mod; int slot;
    __device__ __forceinline__ void operator()(const f32x4 (&acc)[2][2][4][2], const pg8::Unit& u, int wr, int wc, int fr, int fq) const {
        const int row0 = u.pm * 256 + wr * 64 + fr; const int col0 = u.pn * 256 + wc * 32 + 4 * fq;
#pragma unroll
        for (int ai = 0; ai < 2; ++ai)
#pragma unroll
            for (int m = 0; m < 4; ++m) { const int row = row0 + ai * 128 + m * 16;
                const float* ip; float* op; int b;
                if (row < ML_ROWS) { b = row >> 11; ip = xi + (size_t)row * D; op = xo + (size_t)row * D; }
                else { b = 8; ip = ci + (size_t)(row - ML_ROWS) * D; op = co + (size_t)(row - ML_ROWS) * D; }
                const float* gp = mod + (size_t)b * 12288 + slot * 2048;
#pragma unroll
                for (int bj = 0; bj < 2; ++bj)
#pragma unroll
                    for (int n = 0; n < 2; ++n) { const int c = col0 + bj * 128 + n * 16;
                        const f32x4 r = *(const f32x4*)(ip + c), g = *(const f32x4*)(gp + c);
                        *(f32x4*)(op + c) = r + g * acc[ai][bj][m][n]; } }
    }
};

struct WtJob { const float* W; bf16_t* WT; int K, N, kt, nt; };
__device__ __forceinline__ WtJob wt_job(const Params& p, int it) {
    constexpr int T_IN = 32 * 112, T_OUT = 32 * 32, T_FF1 = 32 * 128, T_FF2 = 128 * 32, T_L = T_IN + T_OUT + T_FF1 + T_FF2;
    const int l = it / T_L; int r = it % T_L; bf16_t* wt = (bf16_t*)(p.ws + WS_WT + (size_t)l * WT_LAYER); WtJob j;
    if (r < T_IN) { j.W = p.in[I_WIN] + (size_t)l * 2048 * NIN; j.WT = wt + WT_IN_OFF / 2; j.K = 2048; j.N = NIN; j.kt = r % 32; j.nt = r / 32; }
    else if ((r -= T_IN) < T_OUT) { j.W = p.in[I_WOUT] + (size_t)l * 2048 * 2048; j.WT = wt + WT_OUT_OFF / 2; j.K = 2048; j.N = 2048; j.kt = r % 32; j.nt = r / 32; }
    else if ((r -= T_OUT) < T_FF1) { j.W = p.in[I_WFF1] + (size_t)l * 2048 * 8192; j.WT = wt + WT_FF1_OFF / 2; j.K = 2048; j.N = 8192; j.kt = r % 32; j.nt = r / 32; }
    else { r -= T_FF1; j.W = p.in[I_WFF2] + (size_t)l * 8192 * 2048; j.WT = wt + WT_FF2_OFF / 2; j.K = 8192; j.N = 2048; j.kt = r % 128; j.nt = r / 128; }
    return j;
}
__device__ __forceinline__ void phase_prologue(const Params& p, LAS unsigned char* lds) {
    const int tid = opaque_tid(), G = gridDim.x, bid = blockIdx.x;
    unsigned char* ws = p.ws;
    { float* rc = (float*)(ws + WS_ROPE); float* rs = rc + 2048 * 48;
      for (int i = bid * NTHREADS + tid; i < 2048 * 48; i += G * NTHREADS) { const int t = i / 48, a = i % 48; const int f = a % 24;
          const float inv = powf(10000.0f, -(float)f / 24.0f); const float pos = (a < 24) ? (float)(t / 64) : (float)(t % 64); const float ang = pos * inv;
          rc[i] = cosf(ang); rs[i] = sinf(ang); } }
    { LAS float* sl = (LAS float*)lds; LAS float* red = sl + 9 * 2048;
      bool loaded = false;
      for (int item = bid; item < 384; item += G) {
          if (!loaded) { for (int i = tid; i < 9 * 2048; i += NTHREADS) { const float v = (i < 8 * 2048) ? p.in[I_C][i] : p.in[I_CCTX][i - 8 * 2048]; sl[i] = siluf(v); } loaded = true; __syncthreads(); }
          const int l = item / 192, n0 = (item % 192) * 64; const int kq = tid >> 6, col = tid & 63;
          const float* W = p.in[I_WMOD] + (size_t)l * 2048 * 12288 + n0 + col;
          float acc[9];
#pragma unroll
          for (int r = 0; r < 9; ++r) acc[r] = 0.f;
          for (int k0 = kq * 256; k0 < kq * 256 + 256; k0 += 16) { float w[16];
#pragma unroll
              for (int i = 0; i < 16; ++i) w[i] = W[(size_t)(k0 + i) * 12288];
#pragma unroll
              for (int i4 = 0; i4 < 4; ++i4)
#pragma unroll
                  for (int r = 0; r < 9; ++r) { const f32x4 s = *(const LAS f32x4*)(sl + r * 2048 + k0 + i4 * 4); acc[r] += s[0] * w[i4 * 4] + s[1] * w[i4 * 4 + 1] + s[2] * w[i4 * 4 + 2] + s[3] * w[i4 * 4 + 3]; } }
#pragma unroll
          for (int r = 0; r < 9; ++r) red[(kq * 9 + r) * 64 + col] = acc[r];
          __syncthreads();
          for (int idx = tid; idx < 576; idx += NTHREADS) { const int r = idx >> 6, cc = idx & 63; float s = 0.f;
#pragma unroll
              for (int q = 0; q < 8; ++q) s += red[(q * 9 + r) * 64 + cc];
              ((float*)(ws + WS_MOD))[((size_t)l * 9 + r) * 12288 + n0 + cc] = s + p.in[I_BMOD][l * 12288 + n0 + cc]; }
          __syncthreads();
      }
      __syncthreads();
    }
    { LAS float* z = (LAS float*)lds; LAS float* h1 = z + 8 * 36;
      for (int item = bid; item < 544; item += G) {
          int l, Ls, i0; float* HD;
          if (item < 512) { l = item >> 8; Ls = SEQ; i0 = (item & 255) * 8; HD = (float*)(ws + WS_HD) + (size_t)l * 2048 * 64; }
          else { l = 0; Ls = LC; i0 = (item - 512) * 8; HD = (float*)(ws + WS_HD) + (size_t)2 * 2048 * 64; }
          if (tid < 264) { const int pos = tid / 33, e = tid % 33; const int i = i0 + pos;
              const float t = (float)i / (float)(Ls - 1); const float w = (6.283185307179586f / (float)Ls) * (float)i; float v;
              if (e == 0) v = t; else { const int k = (e - 1) & 15; const float band = 1e-4f + (float)k * ((15.0f - 1e-4f) / 15.0f); const float a = band * w; v = (e <= 16) ? cosf(a) : -sinf(a); }
              z[pos * 36 + e] = v; }
          __syncthreads();
          const int pos = tid >> 6, j = tid & 63;
          { float s = p.in[I_HB1][l * 64 + j]; const float* w1 = p.in[I_HW1] + (size_t)l * 33 * 64 + j;
            for (int e = 0; e < 33; ++e) s += z[pos * 36 + e] * w1[e * 64];
            h1[pos * 64 + j] = sinf(p.in[I_HFREQ][l * 64 + j] * s); }
          __syncthreads();
          { float s = p.in[I_HB2][l * 64 + j]; const float* w2 = p.in[I_HW2] + (size_t)l * 64 * 64 + j;
            for (int e = 0; e < 64; ++e) s += h1[pos * 64 + e] * w2[e * 64];
            HD[(size_t)(i0 + pos) * 64 + j] = sinf(p.in[I_HFREQ][l * 64 + j] * s); }
          __syncthreads();
      }
    }
    { LAS float* tile = (LAS float*)lds;
      constexpr int T_ALL = 2 * (32 * 112 + 32 * 32 + 32 * 128 + 128 * 32);
      for (int it0 = bid * 4; it0 < T_ALL; it0 += G * 4) {
          float4 v[4][2];
#pragma unroll
          for (int q = 0; q < 4; ++q) { const WtJob j = wt_job(p, it0 + q); const int k0 = j.kt * 64, n0 = j.nt * 64;
#pragma unroll
              for (int pp = 0; pp < 2; ++pp) { const int kk = (tid >> 4) + pp * 32, n4 = (tid & 15) * 4;
                  v[q][pp] = make_float4(0.f, 0.f, 0.f, 0.f);
                  if (n0 + n4 < j.N) v[q][pp] = *(const float4*)(j.W + (size_t)(k0 + kk) * j.N + n0 + n4); } }
#pragma unroll
          for (int q = 0; q < 4; ++q)
#pragma unroll
              for (int pp = 0; pp < 2; ++pp) { const int kk = (tid >> 4) + pp * 32, n4 = (tid & 15) * 4; LAS float* t = tile + q * 64 * 65;
                  t[(n4 + 0) * 65 + kk] = v[q][pp].x; t[(n4 + 1) * 65 + kk] = v[q][pp].y; t[(n4 + 2) * 65 + kk] = v[q][pp].z; t[(n4 + 3) * 65 + kk] = v[q][pp].w; }
          __syncthreads();
#pragma unroll
          for (int q = 0; q < 4; ++q) { const WtJob j = wt_job(p, it0 + q); const int k0 = j.kt * 64, n0 = j.nt * 64; const int nn = tid >> 3, k8 = (tid & 7) * 8; float f[8];
#pragma unroll
              for (int i = 0; i < 8; ++i) f[i] = tile[q * 64 * 65 + nn * 65 + k8 + i];
              *(u32x4*)(j.WT + (size_t)(n0 + nn) * j.K + k0 + k8) = pack8(f); }
          __syncthreads();
      }
    }
}

__device__ __forceinline__ void filter_items(const Params& p, LAS unsigned char* lds, int item0, int stride) {
    const int tid = opaque_tid(); unsigned char* ws = p.ws;
    LAS float* hd = (LAS float*)lds;
    LAS float* red = hd + 256 * 64;
    for (int item = item0; item < 136; item += stride) {
        int l, cg, isl, Ls; const float* HD; float* FX; float* NP;
        if (item < 128) { l = item >> 6; cg = (item >> 3) & 7; isl = item & 7; Ls = SEQ; HD = (const float*)(ws + WS_HD) + (size_t)l * 2048 * 64; FX = (float*)(ws + WS_FX) + (size_t)l * 4096 * 512;
            NP = (float*)(ws + WS_NORM) + (size_t)(l * 8 + isl) * 512; }
        else { l = 0; cg = item - 128; isl = 0; Ls = LC; HD = (const float*)(ws + WS_HD) + (size_t)2 * 2048 * 64; FX = (float*)(ws + WS_FC); NP = (float*)(ws + WS_NORM) + (size_t)16 * 512; }
        const int i0 = isl * 256;
        __syncthreads();
        for (int i = tid; i < 256 * 64; i += NTHREADS) hd[i] = HD[(size_t)i0 * 64 + i];
        __syncthreads();
        const int c = tid & 63, dir = (tid >> 6) & 1, sub = tid >> 7; const int ch = cg * 64 + c;
        float w3[64];
        { const float* w3p = p.in[I_HW3] + (size_t)l * 64 * 1024 + dir * 512 + ch;
#pragma unroll
          for (int j = 0; j < 64; ++j) w3[j] = w3p[j * 1024]; }
        const float lo = -4.605170185988091f / 1.5f, hi = -4.605170185988091f / 0.3f;
        const float delta = fabsf(lo + (float)ch * ((hi - lo) / 511.0f));
        float asum = 0.f;
        for (int ii = 0; ii < 64; ++ii) { const int li = sub * 64 + ii; const int pos = i0 + li;
            float dot = 0.f;
#pragma unroll
            for (int j4 = 0; j4 < 16; ++j4) { const f32x4 h = *(const LAS f32x4*)(hd + li * 64 + j4 * 4);
                dot += h[0] * w3[j4 * 4] + h[1] * w3[j4 * 4 + 1] + h[2] * w3[j4 * 4 + 2] + h[3] * w3[j4 * 4 + 3]; }
            const float t = (float)pos / (float)(Ls - 1);
            const float val = dot * __expf(-t * delta);
            if (!(dir == 1 && pos == 0)) { const int lag = dir ? -pos : pos; FX[(size_t)(lag + Ls - 1) * 512 + ch] = val; asum += fabsf(val); } }
        red[(tid >> 6) * 64 + c] = asum;
        __syncthreads();
        if (tid < 64) { float s = 0.f;
#pragma unroll
            for (int q = 0; q < 8; ++q) s += red[q * 64 + tid];
            NP[cg * 64 + tid] = s; }
    }
    __syncthreads();
}

__device__ __forceinline__ void phase_norm_mod(const float* __restrict__ xl, const float* __restrict__ xc, const float* __restrict__ g, const float* __restrict__ mod, int slot_shift, int nrows, bf16_t* __restrict__ act) {
    const int tidq = opaque_tid(); const int lane = tidq & 63; const int nw = gridDim.x * 8;
    const int vbq = (gridDim.x % 8 == 0) ? (blockIdx.x & 7) * (gridDim.x >> 3) + (blockIdx.x >> 3) : blockIdx.x; const int gw = vbq * 8 + (tidq >> 6);
    const int per = (nrows + nw - 1) / nw; const int r0 = gw * per; const int r1 = (r0 + per < nrows) ? r0 + per : nrows;
    int curb = -1; f32x4 fa[8], fb[8];
    for (int row = r0; row < r1; row += 2) {
        const bool two = row + 1 < r1; const int rowb = two ? row + 1 : row;
        const float* s0 = (row < ML_ROWS) ? xl + (size_t)row * D : xc + (size_t)(row - ML_ROWS) * D;
        const float* s1 = (rowb < ML_ROWS) ? xl + (size_t)rowb * D : xc + (size_t)(rowb - ML_ROWS) * D;
        f32x4 v0[8], v1[8]; float ss0 = 0.f, ss1 = 0.f;
#pragma unroll
        for (int i = 0; i < 8; ++i) { v0[i] = *(const f32x4*)(s0 + i * 256 + lane * 4); v1[i] = *(const f32x4*)(s1 + i * 256 + lane * 4); }
#pragma unroll
        for (int i = 0; i < 8; ++i) { ss0 += v0[i][0] * v0[i][0] + v0[i][1] * v0[i][1] + v0[i][2] * v0[i][2] + v0[i][3] * v0[i][3]; ss1 += v1[i][0] * v1[i][0] + v1[i][1] * v1[i][1] + v1[i][2] * v1[i][2] + v1[i][3] * v1[i][3]; }
        ss0 = wave_sum(ss0); ss1 = wave_sum(ss1);
#pragma unroll
        for (int h = 0; h < 2; ++h) { if (h == 1 && !two) break;
            const int rr = h ? rowb : row; const int b = (rr < ML_ROWS) ? (rr >> 11) : 8;
            if (b != curb) { curb = b; const float* sh = mod + (size_t)b * 12288 + slot_shift * 2048; const float* sc = sh + 2048;
#pragma unroll
                for (int i = 0; i < 8; ++i) { const int c = i * 256 + lane * 4; const f32x4 gg = *(const f32x4*)(g + c), s1v = *(const f32x4*)(sc + c); fb[i] = *(const f32x4*)(sh + c); fa[i] = gg * (s1v + 1.0f); } }
            const float r = rsqrtf((h ? ss1 : ss0) * (1.0f / D) + EPS);
#pragma unroll
            for (int i = 0; i < 8; ++i) { const int c = i * 256 + lane * 4; const f32x4 x = h ? v1[i] : v0[i]; const f32x4 o = (x * r) * fa[i] + fb[i];
                u32x2 w; w.x = cvt_pk_bf16(o[0], o[1]); w.y = cvt_pk_bf16(o[2], o[3]);
                *(u32x2*)(act + (size_t)rr * D + c) = w; } }
    }
}

__device__ __forceinline__ void phase_qk(const Params& p, int l) {
    const int tidq = opaque_tid(); unsigned char* ws = p.ws;
    const bf16_t* P = (const bf16_t*)(ws + WS_PH); bf16_t* QK = (bf16_t*)(ws + WS_ACT) + 512;
    const float* cw = p.in[I_MLCW] + (size_t)l * 3 * 1536;
    const int nunits = (MT_ROWS / 4) * 192;
    for (int u = blockIdx.x * NTHREADS + tidq; u < nunits; u += gridDim.x * NTHREADS) { const int cg = u % 192, r0 = (u / 192) * 4; const int c0 = cg * 8;
        const int seg_lo = (r0 < ML_ROWS) ? (r0 & ~2047) : (ML_ROWS + ((r0 - ML_ROWS) & ~255)); const int seg_hi = seg_lo + ((r0 < ML_ROWS) ? SEQ : LC);
        u32x4 raw[6];
#pragma unroll
        for (int t = 0; t < 6; ++t) { const int row = r0 - 1 + t; raw[t] = (row >= seg_lo && row < seg_hi) ? *(const u32x4*)(P + (size_t)row * NINP + C_MLQ + c0) : (u32x4){0u, 0u, 0u, 0u}; }
        float w0[8], w1[8], w2[8];
#pragma unroll
        for (int i = 0; i < 8; ++i) { w0[i] = cw[c0 + i]; w1[i] = cw[1536 + c0 + i]; w2[i] = cw[3072 + c0 + i]; }
        const float sc = (c0 >= 768) ? 0.07216878364870322f : 1.0f;
#pragma unroll
        for (int rr = 0; rr < 4; ++rr) { float xa[8], xb[8], xc[8], o[8]; unpack8(raw[rr], xa); unpack8(raw[rr + 1], xb); unpack8(raw[rr + 2], xc);
#pragma unroll
            for (int i = 0; i < 8; ++i) { const float v = w0[i] * xa[i] + w1[i] * xb[i] + w2[i] * xc[i]; o[i] = siluf(v) * sc; }
            *(u32x4*)(QK + (size_t)(r0 + rr) * D + c0) = pack8(o); } }
}

__device__ __forceinline__ f32x4 mfma16(const bf16x8 a, const bf16x8 b, const f32x4 c) { return __builtin_amdgcn_mfma_f32_16x16x32_bf16(a, b, c, 0, 0, 0); }

template <int DK, int NT, bool IS_ML>
__device__ __forceinline__ void scan_chain(const Params& p, int l, int item, LAS unsigned char* lds) {
    constexpr int LDQ = DK + 8, LDS2 = 136, LDC = DK + 8, KS = DK / 32, DPG = IS_ML ? 6 : 3, CG8 = DK / 8;
    constexpr int R0B = (128 * LDQ * 2 > 128 * LDS2 * 2) ? 128 * LDQ * 2 : 128 * LDS2 * 2;
    constexpr int R1B = (128 * LDQ * 2 > DK * LDS2 * 2) ? 128 * LDQ * 2 : DK * LDS2 * 2;
    constexpr int R2B = NT * 16 * LDS2 * 2, R3B = NT * 16 * LDC * 2;
    constexpr int NKR = (128 * CG8 + NTHREADS - 1) / NTHREADS;
    LAS bf16_t* Qs = (LAS bf16_t*)lds;
    LAS bf16_t* Ks = (LAS bf16_t*)(lds + R0B);
    LAS bf16_t* Vt = (LAS bf16_t*)(lds + R0B + R1B);
    LAS bf16_t* Ct = (LAS bf16_t*)(lds + R0B + R1B + R2B);
    LAS float* vec = (LAS float*)(lds + R0B + R1B + R2B + R3B);
    LAS float* colterm = vec; LAS float* rowterm = vec + 128; LAS float* winter = vec + 256; LAS float* wkv = vec + 384; LAS float* oscale = vec + 512; LAS float* scal = vec + 640;
    static_assert(R0B + R1B + R2B + R3B + 656 * 4 <= LDS_BYTES - 64, "LDS");

    int tid_ = threadIdx.x; asm volatile("" : "+v"(tid_));
    const int tid = tid_, wid = __builtin_amdgcn_readfirstlane(tid >> 6), lane = tid & 63, fr = lane & 15, fq = lane >> 4;
    const int sl = item & 3, dir = (item >> 2) & 1, h = (item >> 3) & 3, b = item >> 5;
    unsigned char* ws = p.ws;
    const bf16_t* P = (const bf16_t*)(ws + WS_PH);
    bf16_t* OUT = (bf16_t*)(ws + (IS_ML ? WS_OM : WS_OR) + (size_t)dir * OMR_DIR);
    const float* GATE = (const float*)(ws + WS_GATE);
    const float* ropec = (const float*)(ws + WS_ROPE); const float* ropes = ropec + 2048 * 48;

    __syncthreads();
    for (int i = tid; i < NT * 16 * LDC / 2; i += NTHREADS) ((LAS unsigned*)Ct)[i] = 0u;
    if (IS_ML) { for (int u = tid; u < 16 * 128; u += NTHREADS) { const int e = 48 + (u >> 7), j = u & 127; Vt[e * LDS2 + j] = (e == 48) ? (bf16_t)0x3F80 : (bf16_t)0; } }
    if (!IS_ML) { const float lg = -__expf(p.in[I_RTLD][l * 8 + dir * 4 + h]);
        if (tid < 128) { const float j = (float)tid; colterm[tid] = __expf(-lg * j); rowterm[tid] = __expf(lg * j); winter[tid] = __expf(lg * (j + 1.0f)); wkv[tid] = __expf(lg * (127.0f - j)); oscale[tid] = 0.f; }
        if (tid == 0) { scal[0] = __expf(lg * 128.0f); scal[1] = 0.f; } }
    if (IS_ML && tid == 0) { float one = 1.0f, zero = 0.f; asm volatile("" : "+v"(one), "+v"(zero)); scal[0] = one; scal[1] = zero; }
    f32x4 accC[DPG];
#pragma unroll
    for (int i = 0; i < DPG; ++i) accC[i] = (f32x4){0.f, 0.f, 0.f, 0.f};
    float gbi = 0.f, gbf = 0.f;
    if (IS_ML) { gbi = p.in[I_MLGB][l * 16 + dir * 8 + h]; gbf = p.in[I_MLGB][l * 16 + dir * 8 + 4 + h]; }
    __syncthreads();

    const int tid_chain = tid;
    for (int step = 0; step < 18; ++step) {
        int tq_ = tid_chain; asm volatile("" : "+v"(tq_));
        const int tid = tq_, wid = __builtin_amdgcn_readfirstlane(tid >> 6), lane = tid & 63, fr = lane & 15, fq = lane >> 4;
        const bool isctx = step < 2; const int nch = isctx ? 2 : 16; const int ci = isctx ? step : step - 2; const int chunk = dir ? (nch - 1 - ci) : ci;
        const int seg_lo = isctx ? (ML_ROWS + b * LC) : b * SEQ; const int seg_hi = seg_lo + (isctx ? LC : SEQ);
        const int rowbase = seg_lo + chunk * 128;
        u32x4 vreg[2]; float g_i = 0.f, g_f = 0.f;
        { const int vc = (IS_ML ? C_MLV : C_RV) + h * 192 + sl * 48;
#pragma unroll
          for (int k = 0; k < 2; ++k) { const int u = tid + k * NTHREADS; vreg[k] = (u32x4){0u, 0u, 0u, 0u};
              if (u < 128 * 6) { const int j = u & 127, e0 = (u >> 7) * 8; const int row = dir ? rowbase + 127 - j : rowbase + j; vreg[k] = *(const u32x4*)(P + (size_t)row * NINP + vc + e0); } }
          if (IS_ML && tid < 128) { const int row = dir ? rowbase + 127 - tid : rowbase + tid; g_i = GATE[(size_t)row * 16 + dir * 8 + h]; g_f = GATE[(size_t)row * 16 + dir * 8 + 4 + h]; } }
        if (IS_ML) {
            { const bf16_t* QK = (const bf16_t*)(ws + WS_ACT) + 512 + h * 192; u32x4 raw[12];
#pragma unroll
              for (int k = 0; k < 12; ++k) { const int u = tid + k * NTHREADS; const int cgq = u % 48, rch = u / 48; raw[k] = *(const u32x4*)(QK + (size_t)(rowbase + rch) * D + ((cgq >= 24) ? 768 : 0) + (cgq % 24) * 8); }
#pragma unroll
              for (int k = 0; k < 12; ++k) { const int u = tid + k * NTHREADS; const int cgq = u % 48, rch = u / 48; const int j = dir ? 127 - rch : rch;
                  *(LAS u32x4*)(((cgq >= 24) ? Ks : Qs) + j * LDQ + (cgq % 24) * 8) = raw[k]; } }
        } else {
            for (int u = tid; u < 128 * 6; u += NTHREADS) { const int j = u / 6, d0 = (u % 6) * 8; const int row = dir ? rowbase + 127 - j : rowbase + j;
                float cs[8], sn[8];
                if (!isctx) { const int t = row - seg_lo;
#pragma unroll
                    for (int i = 0; i < 8; ++i) { cs[i] = ropec[t * 48 + d0 + i]; sn[i] = ropes[t * 48 + d0 + i]; } }
                else {
#pragma unroll
                    for (int i = 0; i < 8; ++i) { cs[i] = 1.f; sn[i] = 0.f; } }
#pragma unroll
                for (int qk = 0; qk < 2; ++qk) { const int pc = (qk ? C_RK : C_RQ) + h * 96 + d0; const bf16_t* pr = P + (size_t)row * NINP + pc;
                    float a1[8], a2[8], o1[8], o2[8]; unpack8(*(const u32x4*)pr, a1); unpack8(*(const u32x4*)(pr + 48), a2);
                    const float sc = qk ? 1.0f : 0.10206207261596575f;
#pragma unroll
                    for (int i = 0; i < 8; ++i) { o1[i] = (a1[i] * cs[i] - a2[i] * sn[i]) * sc; o2[i] = (a1[i] * sn[i] + a2[i] * cs[i]) * sc; }
                    LAS bf16_t* dst = (qk ? Ks : Qs) + j * LDQ + d0;
                    *(LAS u32x4*)dst = pack8(o1); *(LAS u32x4*)(dst + 48) = pack8(o2); } }
        }
#pragma unroll
        for (int k = 0; k < 2; ++k) { const int u = tid + k * NTHREADS; if (u < 128 * 6) { const int j = u & 127, e0 = (u >> 7) * 8; const u32x4 v = vreg[k];
              Vt[(e0 + 0) * LDS2 + j] = (bf16_t)(v.x & 0xFFFFu); Vt[(e0 + 1) * LDS2 + j] = (bf16_t)(v.x >> 16);
              Vt[(e0 + 2) * LDS2 + j] = (bf16_t)(v.y & 0xFFFFu); Vt[(e0 + 3) * LDS2 + j] = (bf16_t)(v.y >> 16);
              Vt[(e0 + 4) * LDS2 + j] = (bf16_t)(v.z & 0xFFFFu); Vt[(e0 + 5) * LDS2 + j] = (bf16_t)(v.z >> 16);
              Vt[(e0 + 6) * LDS2 + j] = (bf16_t)(v.w & 0xFFFFu); Vt[(e0 + 7) * LDS2 + j] = (bf16_t)(v.w >> 16); } }
        if (IS_ML) { if (tid < 128) { colterm[tid] = g_i + gbi; const float gf = g_f + gbf; rowterm[tid] = fminf(gf, 0.f) - log1pf(__expf(-fabsf(gf))); } }
        __syncthreads();
        if (IS_ML) {
            if (wid == 0) {
                const float mprev = scal[1];
                const int j0 = 2 * lane, j1 = j0 + 1;
                const float i0 = colterm[j0], i1 = colterm[j1], f0 = rowterm[j0], f1 = rowterm[j1];
                float s = f0 + f1;
#pragma unroll
                for (int o = 1; o < 64; o <<= 1) { const float t = __shfl_up(s, o); if (lane >= o) s += t; }
                const float excl = s - (f0 + f1);
                const float b0 = excl + f0, b1 = excl + f0 + f1;
                const float a0 = i0 - b0, a1 = i1 - b1;
                float mx = fmaxf(a0, a1);
#pragma unroll
                for (int o = 1; o < 64; o <<= 1) { const float t = __shfl_up(mx, o); if (lane >= o) mx = fmaxf(mx, t); }
                float exm = __shfl_up(mx, 1); if (lane == 0) exm = -3.0e38f;
                const float M0 = fmaxf(fmaxf(mprev, exm), a0), M1 = fmaxf(M0, a1);
                const float Mlast = __shfl(M1, 63); const float bend = __shfl(b1, 63);
                colterm[j0] = a0; colterm[j1] = a1; rowterm[j0] = M0; rowterm[j1] = M1;
                winter[j0] = __expf(mprev - M0); winter[j1] = __expf(mprev - M1);
                wkv[j0] = __expf(a0 - Mlast); wkv[j1] = __expf(a1 - Mlast);
                oscale[j0] = __expf(-(b0 + M0)); oscale[j1] = __expf(-(b1 + M1));
                if (lane == 0) { scal[0] = __expf(mprev - Mlast); scal[1] = bend + Mlast; }
            }
            __syncthreads();
        }
        const float decay = scal[0];
        const int tt = (wid < 4) ? wid : 11 - wid;
        const int trow = 16 * tt + fr;
        bf16x8 qf[KS];
#pragma unroll
        for (int ks = 0; ks < KS; ++ks) qf[ks] = *(const LAS bf16x8*)(Qs + trow * LDQ + ks * 32 + fq * 8);
        f32x4 accO[NT];
        { bf16x8 cf[2][KS];
#pragma unroll
          for (int ks = 0; ks < KS; ++ks) cf[0][ks] = *(const LAS bf16x8*)(Ct + fr * LDC + ks * 32 + fq * 8);
#pragma unroll
          for (int nt = 0; nt < NT; ++nt) { accO[nt] = (f32x4){0.f, 0.f, 0.f, 0.f};
              if (nt + 1 < NT) {
#pragma unroll
                  for (int ks = 0; ks < KS; ++ks) cf[(nt + 1) & 1][ks] = *(const LAS bf16x8*)(Ct + (16 * (nt + 1) + fr) * LDC + ks * 32 + fq * 8); }
#pragma unroll
              for (int ks = 0; ks < KS; ++ks) accO[nt] = mfma16(cf[nt & 1][ks], qf[ks], accO[nt]); } }
        { const float wi = winter[trow];
#pragma unroll
          for (int nt = 0; nt < NT; ++nt) accO[nt] *= wi; }
        f32x4 accS[8];
        { bf16x8 kf[2][KS];
#pragma unroll
          for (int ks = 0; ks < KS; ++ks) kf[0][ks] = *(const LAS bf16x8*)(Ks + fr * LDQ + ks * 32 + fq * 8);
#pragma unroll
          for (int ns = 0; ns < 8; ++ns) { accS[ns] = (f32x4){0.f, 0.f, 0.f, 0.f};
              if (ns <= tt) {
                  if (ns + 1 <= tt && ns + 1 < 8) {
#pragma unroll
                      for (int ks = 0; ks < KS; ++ks) kf[(ns + 1) & 1][ks] = *(const LAS bf16x8*)(Ks + (16 * (ns + 1) + fr) * LDQ + ks * 32 + fq * 8); }
#pragma unroll
                  for (int ks = 0; ks < KS; ++ks) accS[ns] = mfma16(kf[ns & 1][ks], qf[ks], accS[ns]); } } }
        u32x4 kreg[NKR];
#pragma unroll
        for (int q = 0; q < NKR; ++q) { const int u = tid + q * NTHREADS; if (u < 128 * CG8) { const int j = u & 127, d0 = (u >> 7) * 8; kreg[q] = *(const LAS u32x4*)(Ks + j * LDQ + d0); } else kreg[q] = (u32x4){0u, 0u, 0u, 0u}; }
        __syncthreads();
        { const float rt = rowterm[trow];
#pragma unroll
          for (int ns = 0; ns < 8; ++ns) { u32x2 w = (u32x2){0u, 0u};
              if (ns <= tt) { float v[4]; const f32x4 ct = *(const LAS f32x4*)(colterm + 16 * ns + fq * 4);
#pragma unroll
                  for (int jj = 0; jj < 4; ++jj) { const int s = 16 * ns + fq * 4 + jj; const float e = (IS_ML ? __expf(fminf(ct[jj] - rt, 0.f)) : ct[jj] * rt) * ((s <= trow) ? 1.0f : 0.0f); v[jj] = accS[ns][jj] * e; }
                  w.x = cvt_pk_bf16(v[0], v[1]); w.y = cvt_pk_bf16(v[2], v[3]); }
              *(LAS u32x2*)(Qs + trow * LDS2 + 16 * ns + fq * 4) = w; } }
#pragma unroll
        for (int q = 0; q < NKR; ++q) { const int u = tid + q * NTHREADS; if (u < 128 * CG8) { const int j = u & 127, d0 = (u >> 7) * 8; float f[8]; unpack8(kreg[q], f); const float wk = wkv[j];
#pragma unroll
                for (int i = 0; i < 8; ++i) Ks[(d0 + i) * LDS2 + j] = f2bf(f[i] * wk); } }
        __syncthreads();
#pragma unroll
        for (int ks = 0; ks < 4; ++ks) { if (ks * 2 <= tt) { const bf16x8 sf = *(const LAS bf16x8*)(Qs + trow * LDS2 + ks * 32 + fq * 8);
#pragma unroll
                for (int nt = 0; nt < NT; ++nt) { const bf16x8 vf = *(const LAS bf16x8*)(Vt + (16 * nt + fr) * LDS2 + ks * 32 + fq * 8); accO[nt] = mfma16(vf, sf, accO[nt]); } } }
        { float inv = 1.0f;
          if (IS_ML) { const float den = __shfl(accO[NT - 1][0], fr); inv = 1.0f / fmaxf(fabsf(den), oscale[trow]); }
          const int row = dir ? rowbase + 127 - trow : rowbase + trow;
          bf16_t* op = OUT + ((size_t)(h * 4 + sl) * MT_ROWS + row) * 48 + fq * 4;
#pragma unroll
          for (int nt = 0; nt < 3; ++nt) { u32x2 w; w.x = cvt_pk_bf16(accO[nt][0] * inv, accO[nt][1] * inv); w.y = cvt_pk_bf16(accO[nt][2] * inv, accO[nt][3] * inv); *(u32x2*)(op + nt * 16) = w; } }
        if (wid < 2 * NT) { const int et = wid % NT, grp = wid / NT;
            bf16x8 vf4[4];
#pragma unroll
            for (int ks = 0; ks < 4; ++ks) vf4[ks] = *(const LAS bf16x8*)(Vt + (16 * et + fr) * LDS2 + ks * 32 + fq * 8);
            bf16x8 kw[2][4];
#pragma unroll
            for (int ks = 0; ks < 4; ++ks) kw[0][ks] = *(const LAS bf16x8*)(Ks + (16 * (grp * DPG) + fr) * LDS2 + ks * 32 + fq * 8);
#pragma unroll
            for (int dt = 0; dt < DPG; ++dt) { const int dtile = grp * DPG + dt; accC[dt] *= decay;
                if (dt + 1 < DPG) {
#pragma unroll
                    for (int ks = 0; ks < 4; ++ks) kw[(dt + 1) & 1][ks] = *(const LAS bf16x8*)(Ks + (16 * (dtile + 1) + fr) * LDS2 + ks * 32 + fq * 8); }
#pragma unroll
                for (int ks = 0; ks < 4; ++ks) accC[dt] = mfma16(kw[dt & 1][ks], vf4[ks], accC[dt]);
                u32x2 w; w.x = cvt_pk_bf16(accC[dt][0], accC[dt][1]); w.y = cvt_pk_bf16(accC[dt][2], accC[dt][3]);
                *(LAS u32x2*)(Ct + (16 * et + fr) * LDC + 16 * dtile + fq * 4) = w; } }
        __syncthreads();
    }
}

template <int LS>
__device__ __forceinline__ void hyena_item(const Params& p, int l, int b, int cg, int tb, bool isctx, LAS unsigned char* lds) {
    const int tid_ = opaque_tid();
    const int lane = tid_ & 63, wid = __builtin_amdgcn_readfirstlane(tid_ >> 6); unsigned char* ws = p.ws;
    LAS float* zs = (LAS float*)lds;
    LAS float* fs = zs + 64 * 64;
    const int ch = cg * 64 + lane; const int seg_lo = isctx ? (ML_ROWS + b * LC) : b * SEQ;
    const bf16_t* Pb = (const bf16_t*)(ws + WS_PH) + (size_t)seg_lo * NINP + cg * 64;
    bf16_t* Yb = (bf16_t*)(ws + WS_ACT) + (size_t)seg_lo * D + cg * 64;
    const float* FX = (isctx ? (const float*)(ws + WS_FC) : (const float*)(ws + WS_FX) + (size_t)l * 4096 * 512) + cg * 64;
    const float* NP = isctx ? (const float*)(ws + WS_NORM) + 16 * 512 : (const float*)(ws + WS_NORM) + (size_t)l * 8 * 512;
    const float* cw = p.in[I_HYCW] + (size_t)l * 3 * 1536;
    const float wx0a = cw[C_X0 + ch], wx0b = cw[1536 + C_X0 + ch], wx0c = cw[3072 + C_X0 + ch];
    const float wx1a = cw[C_X1 + ch], wx1b = cw[1536 + C_X1 + ch], wx1c = cw[3072 + C_X1 + ch];
    const float wva = cw[C_HV + ch], wvb = cw[1536 + C_HV + ch], wvc = cw[3072 + C_HV + ch];
    const int tblk = tb * 256, t0 = tblk + wid * 32;
    float acc[32];
#pragma unroll
    for (int i = 0; i < 32; ++i) acc[i] = 0.f;
    for (int sc = 0; sc < LS; sc += 64) {
        __syncthreads();
        { const int s8 = sc + wid * 8; const bf16_t* ps = Pb + (size_t)s8 * NINP;
          float pv0 = (s8 > 0) ? bf2f(ps[-NINP + C_HV + lane]) : 0.f, px0 = (s8 > 0) ? bf2f(ps[-NINP + C_X1 + lane]) : 0.f;
          float pv1 = bf2f(ps[C_HV + lane]), px1 = bf2f(ps[C_X1 + lane]);
#pragma unroll
          for (int k = 0; k < 8; ++k) { float pv2 = 0.f, px2 = 0.f;
              if (s8 + k + 1 < LS) { pv2 = bf2f(ps[(k + 1) * NINP + C_HV + lane]); px2 = bf2f(ps[(k + 1) * NINP + C_X1 + lane]); }
              zs[(wid * 8 + k) * 64 + lane] = (wva * pv0 + wvb * pv1 + wvc * pv2) * (wx1a * px0 + wx1b * px1 + wx1c * px2);
              pv0 = pv1; pv1 = pv2; px0 = px1; px1 = px2; } }
        { const int jlo = tblk - sc - 63 + LS - 1;
#pragma unroll 8
          for (int r = wid; r < 319; r += 8) { const int j = jlo + r; fs[r * 64 + lane] = (j >= 0 && j <= 2 * LS - 2) ? FX[(size_t)j * 512 + lane] : 0.f; } }
        __syncthreads();
#pragma unroll 1
        for (int kb = 0; kb < 4; ++kb) {
            float z[16], f[47];
            const int rb = wid * 32 + 48 - kb * 16;
#pragma unroll
            for (int k = 0; k < 16; ++k) z[k] = zs[(kb * 16 + k) * 64 + lane];
#pragma unroll
            for (int i = 0; i < 47; ++i) f[i] = fs[(rb + i) * 64 + lane];
#pragma unroll
            for (int k = 0; k < 16; ++k) {
#pragma unroll
                for (int i = 0; i < 32; ++i) acc[i] += f[15 + i - k] * z[k]; }
        }
    }
    float nsum = 0.f;
    if (isctx) nsum = NP[ch]; else {
#pragma unroll
        for (int q = 0; q < 8; ++q) nsum += NP[q * 512 + ch]; }
    const float inv = 1.0f / nsum; const float bias = p.in[I_HBIAS][l * 512 + ch];
    { const bf16_t* pt = Pb + (size_t)t0 * NINP;
      float m0 = 0.f, m1 = 0.f, m2 = 0.f;
      if (t0 > 0) { m0 = bf2f(pt[-NINP + C_X0 + lane]); m1 = bf2f(pt[-NINP + C_X1 + lane]); m2 = bf2f(pt[-NINP + C_HV + lane]); }
      float a0 = bf2f(pt[C_X0 + lane]), a1 = bf2f(pt[C_X1 + lane]), a2 = bf2f(pt[C_HV + lane]);
#pragma unroll
      for (int i = 0; i < 32; ++i) { float q0 = 0.f, q1 = 0.f, q2 = 0.f;
          if (t0 + i + 1 < LS) { q0 = bf2f(pt[(i + 1) * NINP + C_X0 + lane]); q1 = bf2f(pt[(i + 1) * NINP + C_X1 + lane]); q2 = bf2f(pt[(i + 1) * NINP + C_HV + lane]); }
          const float x0 = wx0a * m0 + wx0b * a0 + wx0c * q0; const float x1 = wx1a * m1 + wx1b * a1 + wx1c * q1; const float vv = wva * m2 + wvb * a2 + wvc * q2;
          const float zt = vv * x1; const float y = (acc[i] * inv + bias * zt) * x0;
          Yb[(size_t)(t0 + i) * D + lane] = f2bf(y);
          m0 = a0; m1 = a1; m2 = a2; a0 = q0; a1 = q1; a2 = q2;
          if ((i & 7) == 7) asm volatile("" ::: "memory"); } }
}

__device__ __forceinline__ void hyena_mfma(const Params& p, int l, int item, LAS unsigned char* lds) {
    constexpr int ZLD = 2056, GLD = 4104;
    const int tid = opaque_tid(); const int lane = tid & 63, wid = __builtin_amdgcn_readfirstlane(tid >> 6), r = lane & 15, q = lane >> 4;
    unsigned char* ws = p.ws;
    LAS bf16_t* ZS = (LAS bf16_t*)lds;
    LAS bf16_t* GS = ZS + 2 * 8 * ZLD;
    const int c0 = item * 2;
    const bf16_t* P = (const bf16_t*)(ws + WS_PH); bf16_t* Y = (bf16_t*)(ws + WS_ACT);
    const float* FX = (const float*)(ws + WS_FX) + (size_t)l * 4096 * 512;
    const float* NP = (const float*)(ws + WS_NORM) + (size_t)l * 8 * 512;
    const float* cw = p.in[I_HYCW] + (size_t)l * 3 * 1536;
    __syncthreads();
    { const int b = tid >> 6, s0 = (tid & 63) * 32;
      float wv[2][3], wx[2][3];
#pragma unroll
      for (int c = 0; c < 2; ++c)
#pragma unroll
          for (int t = 0; t < 3; ++t) { wv[c][t] = cw[t * 1536 + C_HV + c0 + c]; wx[c][t] = cw[t * 1536 + C_X1 + c0 + c]; }
      const bf16_t* pb = P + (size_t)(b * SEQ) * NINP + c0;
      unsigned vr[34], xr_[34];
#pragma unroll
      for (int k = 0; k < 34; ++k) { const int s = s0 - 1 + k; const bool ok = (s >= 0) && (s < SEQ);
          vr[k] = ok ? *(const unsigned*)(pb + (size_t)s * NINP + C_HV) : 0u; xr_[k] = ok ? *(const unsigned*)(pb + (size_t)s * NINP + C_X1) : 0u; }
#pragma unroll
      for (int g = 0; g < 4; ++g) { float za[8], zb[8];
#pragma unroll
          for (int k = 0; k < 8; ++k) { const int i = g * 8 + k; const unsigned v0 = vr[i], v1 = vr[i + 1], v2 = vr[i + 2], x0 = xr_[i], x1 = xr_[i + 1], x2 = xr_[i + 2];
              za[k] = (wv[0][0] * bf_lo(v0) + wv[0][1] * bf_lo(v1) + wv[0][2] * bf_lo(v2)) * (wx[0][0] * bf_lo(x0) + wx[0][1] * bf_lo(x1) + wx[0][2] * bf_lo(x2));
              zb[k] = (wv[1][0] * bf_hi(v0) + wv[1][1] * bf_hi(v1) + wv[1][2] * bf_hi(v2)) * (wx[1][0] * bf_hi(x0) + wx[1][1] * bf_hi(x1) + wx[1][2] * bf_hi(x2)); }
          *(LAS u32x4*)(ZS + (0 * 8 + b) * ZLD + s0 + g * 8) = pack8(za);
          *(LAS u32x4*)(ZS + (1 * 8 + b) * ZLD + s0 + g * 8) = pack8(zb); } }
    f32x4 acc[16];
    const int t0 = wid * 256;
#pragma unroll 1
    for (int c = 0; c < 2; ++c) {
        const int ch = c0 + c;
        __syncthreads();
        { float nsum = 0.f;
#pragma unroll
          for (int qq = 0; qq < 8; ++qq) nsum += NP[qq * 512 + ch];
          const float inv = 1.0f / nsum; const float bias = p.in[I_HBIAS][l * 512 + ch];
#pragma unroll
          for (int i = 0; i < 8; ++i) { const int m = tid + i * 512; float g = 0.f;
              if (m <= 4094) { g = FX[(size_t)(4094 - m) * 512 + ch] * inv; if (m == 2047) g += bias; }
              const bf16_t gb = f2bf(g);
#pragma unroll
              for (int k = 0; k < 8; ++k) { if (m - k >= 0) GS[k * GLD + (m - k)] = gb; } }
        }
        __syncthreads();
        const int kc = (7 - r) & 7;
        const LAS bf16_t* gp = GS + kc * GLD + (2047 - t0 - r + 8 * q - kc);
        const LAS bf16_t* zp = ZS + (c * 8 + (lane & 7)) * ZLD + 8 * q;
        bf16x8 ring[16];
#pragma unroll
        for (int i = 0; i < 16; ++i) { acc[i] = (f32x4){0.f, 0.f, 0.f, 0.f}; ring[i] = *(const LAS bf16x8*)(gp - 16 * i); }
        bf16x8 zf = *(const LAS bf16x8*)zp;
#pragma unroll 1
        for (int J = 0; J < 8; ++J) {
#pragma unroll
            for (int jj = 0; jj < 8; ++jj) { const int j = J * 8 + jj;
                bf16x8 rn0 = zf, rn1 = zf, zn = zf;
                if (j + 1 < 64) { rn0 = *(const LAS bf16x8*)(gp + 16 * (2 * (j + 1))); rn1 = *(const LAS bf16x8*)(gp + 16 * (2 * (j + 1) - 1)); zn = *(const LAS bf16x8*)(zp + 32 * (j + 1)); }
#pragma unroll
                for (int i = 0; i < 16; ++i) acc[i] = mfma16(ring[(i - 2 * jj) & 15], zf, acc[i]);
                if (j + 1 < 64) { ring[(16 - 2 * (jj + 1)) & 15] = rn0; ring[(17 - 2 * (jj + 1)) & 15] = rn1; }
                zf = zn; } }
        __syncthreads();
        if (r < 8) { LAS bf16_t* yb_ = ZS + (c * 8 + r) * ZLD + t0 + 4 * q;
#pragma unroll
            for (int i = 0; i < 16; ++i) { u32x2 w; w.x = cvt_pk_bf16(acc[i][0], acc[i][1]); w.y = cvt_pk_bf16(acc[i][2], acc[i][3]); *(LAS u32x2*)(yb_ + 16 * i) = w; } }
    }
    __syncthreads();
    { const int b = tid >> 6;
      float w0[3], w1[3];
#pragma unroll
      for (int t = 0; t < 3; ++t) { w0[t] = cw[t * 1536 + C_X0 + c0]; w1[t] = cw[t * 1536 + C_X0 + c0 + 1]; }
      const bf16_t* pb = P + (size_t)(b * SEQ) * NINP + C_X0 + c0; bf16_t* yb = Y + (size_t)(b * SEQ) * D + c0;
      unsigned xall[8][6];
#pragma unroll
      for (int k = 0; k < 8; ++k) { const int tb = 4 * (tid & 63) + 256 * k;
#pragma unroll
          for (int u = 0; u < 6; ++u) { const int t = tb - 1 + u; xall[k][u] = (t >= 0 && t < SEQ) ? *(const unsigned*)(pb + (size_t)t * NINP) : 0u; } }
#pragma unroll
      for (int k = 0; k < 8; ++k) { const int tb = 4 * (tid & 63) + 256 * k;
          const unsigned* xr = xall[k];
          const u32x2 ya = *(const LAS u32x2*)(ZS + (0 * 8 + b) * ZLD + tb), yc = *(const LAS u32x2*)(ZS + (1 * 8 + b) * ZLD + tb);
          const float y0[4] = {bf_lo(ya.x), bf_hi(ya.x), bf_lo(ya.y), bf_hi(ya.y)}, y1[4] = {bf_lo(yc.x), bf_hi(yc.x), bf_lo(yc.y), bf_hi(yc.y)};
#pragma unroll
          for (int jj = 0; jj < 4; ++jj) {
              const float xa = w0[0] * bf_lo(xr[jj]) + w0[1] * bf_lo(xr[jj + 1]) + w0[2] * bf_lo(xr[jj + 2]);
              const float xb = w1[0] * bf_hi(xr[jj]) + w1[1] * bf_hi(xr[jj + 1]) + w1[2] * bf_hi(xr[jj + 2]);
              *(unsigned*)(yb + (size_t)(tb + jj) * D) = cvt_pk_bf16(y0[jj] * xa, y1[jj] * xb); } } }
    __syncthreads();
}

__device__ __forceinline__ void phase_mixers(const Params& p, int l, LAS unsigned char* lds) {
    const int G = gridDim.x, bid = blockIdx.x;
    const int vb = (G % 8 == 0) ? (bid & 7) * (G >> 3) + (bid >> 3) : bid;
    for (int item = vb; item < 256; item += G) hyena_mfma(p, l, item, lds);
    for (int item = vb; item < 256; item += G) scan_chain<192, 4, true>(p, l, item, lds);
    for (int item = vb; item < 256; item += G) scan_chain<96, 3, false>(p, l, item, lds);
    if (l == 0) { for (int item = G - 1 - bid; item < 64; item += G) hyena_item<LC>(p, l, item >> 3, item & 7, 0, true, lds); }
}

__device__ __forceinline__ void phase_combine(const Params& p, int l, int nrows) {
    const int tidq = opaque_tid(); unsigned char* ws = p.ws; const int lane = tidq & 63; const int gw = blockIdx.x * 8 + (tidq >> 6), nw = gridDim.x * 8;
    const bf16_t* P = (const bf16_t*)(ws + WS_PH); bf16_t* Y = (bf16_t*)(ws + WS_ACT);
    const float* ng = p.in[I_MLNG] + (size_t)l * 768;
    const int li = lane & 31, e0 = 6 * li, sl = li >> 3, ee = 6 * (li & 7);
    const int vbq = (gridDim.x % 8 == 0) ? (blockIdx.x & 7) * (gridDim.x >> 3) + (blockIdx.x >> 3) : blockIdx.x; const int per = (nrows * 4 + nw - 1) / nw; const int ubeg = (vbq * 8 + (tidq >> 6)) * per;
    for (int u = ubeg; u < ubeg + per && u < nrows * 4; ++u) { const int row = u >> 2, grp = (u >> 1) & 1, h = (u & 1) * 2 + (lane >> 5);
        const bf16_t* o0 = (const bf16_t*)(ws + (grp ? WS_OR : WS_OM)) + ((size_t)(h * 4 + sl) * MT_ROWS + row) * 48 + ee; const bf16_t* o1 = o0 + OMR_DIR / 2;
        const bf16_t* gp = P + (size_t)row * NINP + (grp ? C_RG : C_MLO) + h * 192 + e0;
        unsigned a[3], c[3], gt[3];
#pragma unroll
        for (int i = 0; i < 3; ++i) { a[i] = ((const unsigned*)o0)[i]; c[i] = ((const unsigned*)o1)[i]; gt[i] = ((const unsigned*)gp)[i]; }
        float v[6]; float ss = 0.f;
#pragma unroll
        for (int i = 0; i < 3; ++i) { v[2 * i] = bf_lo(a[i]) + bf_lo(c[i]); v[2 * i + 1] = bf_hi(a[i]) + bf_hi(c[i]); ss += v[2 * i] * v[2 * i] + v[2 * i + 1] * v[2 * i + 1]; }
#pragma unroll
        for (int o = 16; o > 0; o >>= 1) ss += __shfl_xor(ss, o);
        const float r = rsqrtf(ss * (1.0f / 192.0f) + EPS);
        float y[6];
#pragma unroll
        for (int i = 0; i < 6; ++i) { const float g = (i & 1) ? bf_hi(gt[i >> 1]) : bf_lo(gt[i >> 1]);
            y[i] = grp ? (v[i] * r * siluf(g)) : (v[i] * r * ng[h * 192 + e0 + i] * sigmf(g)); }
        unsigned* yp = (unsigned*)(Y + (size_t)row * D + (grp ? 1280 : 512) + h * 192 + e0);
#pragma unroll
        for (int i = 0; i < 3; ++i) yp[i] = cvt_pk_bf16(y[2 * i], y[2 * i + 1]); }
}

__device__ __forceinline__ void phase_final(const Params& p) {
    const int tidq = opaque_tid(); const int lane = tidq & 63; const int gw = blockIdx.x * 8 + (tidq >> 6), nw = gridDim.x * 8;
    const float* g = p.in[I_FING];
    const int per = (ML_ROWS + nw - 1) / nw; const int r0 = gw * per; const int r1 = (r0 + per < ML_ROWS) ? r0 + per : ML_ROWS;
    f32x4 gg[8];
#pragma unroll
    for (int i = 0; i < 8; ++i) gg[i] = *(const f32x4*)(g + i * 256 + lane * 4);
    for (int row = r0; row < r1; row += 2) { const bool two = row + 1 < r1; float* s0 = p.out + (size_t)row * D; float* s1 = p.out + (size_t)(two ? row + 1 : row) * D;
        f32x4 v0[8], v1[8]; float ss0 = 0.f, ss1 = 0.f;
#pragma unroll
        for (int i = 0; i < 8; ++i) { v0[i] = *(const f32x4*)(s0 + i * 256 + lane * 4); v1[i] = *(const f32x4*)(s1 + i * 256 + lane * 4); }
#pragma unroll
        for (int i = 0; i < 8; ++i) { ss0 += v0[i][0] * v0[i][0] + v0[i][1] * v0[i][1] + v0[i][2] * v0[i][2] + v0[i][3] * v0[i][3]; ss1 += v1[i][0] * v1[i][0] + v1[i][1] * v1[i][1] + v1[i][2] * v1[i][2] + v1[i][3] * v1[i][3]; }
        ss0 = wave_sum(ss0); ss1 = wave_sum(ss1);
        const float ra = rsqrtf(ss0 * (1.0f / D) + EPS), rb = rsqrtf(ss1 * (1.0f / D) + EPS);
#pragma unroll
        for (int i = 0; i < 8; ++i) { const int c = i * 256 + lane * 4; *(f32x4*)(s0 + c) = v0[i] * ra * gg[i]; if (two) *(f32x4*)(s1 + c) = v1[i] * rb * gg[i]; } }
}

#define XB_TMO      128
#define XB_XCNT(j)  (256  + 64 * (j))
#define XB_XSUB(j)  (1280 + 64 * (j))
#define XB_XGEN(j)  (2304 + 64 * (j))
#define XB_TOP      3328
#define XB_TOPGEN   3392
#define XCD_BAR_WORDS 3456
#define XB_SPIN_CAP (1u << 22)
__device__ __forceinline__ unsigned xb_ld(unsigned* p)              { return __hip_atomic_load(p, __ATOMIC_RELAXED, __HIP_MEMORY_SCOPE_AGENT); }
__device__ __forceinline__ unsigned xb_add(unsigned* p, unsigned v) { return __hip_atomic_fetch_add(p, v, __ATOMIC_RELAXED, __HIP_MEMORY_SCOPE_AGENT); }
__device__ __forceinline__ unsigned xb_xcc_id() { return (unsigned)__builtin_amdgcn_s_getreg((3 << 11) | 20) & 0xFu; }
#define XB_SPIN(cond, bar) do { unsigned _sp = 0; while (cond) { __builtin_amdgcn_s_sleep(1); \
    if ((++_sp & 255u) == 0u) { if (xb_ld(&(bar)[XB_TMO])) break; if (_sp > XB_SPIN_CAP) { atomicAdd(&(bar)[XB_TMO], 1u); break; } } } } while (0)
struct XcdBarrier { unsigned* bar; volatile LAS unsigned* st; };
__device__ __forceinline__ XcdBarrier xcd_barrier_post(unsigned* bar, volatile LAS unsigned* st) {
    XcdBarrier b; b.bar = bar; b.st = st; const unsigned x = (unsigned)__builtin_amdgcn_readfirstlane((int)xb_xcc_id());
    if (threadIdx.x == 0) (void)xb_add(&bar[XB_XCNT(x)], 1u);
    return b;
}
__device__ __forceinline__ void xcd_barrier_complete(unsigned* bar, unsigned x, unsigned& nloc, unsigned& nx) {
    const unsigned G = gridDim.x * gridDim.y * gridDim.z;
    unsigned sum, cnt, mine, sp = 0u;
    for (;;) {
        sum = 0u; cnt = 0u; mine = 0u;
#pragma unroll
        for (unsigned j = 0; j < 16; ++j) { const unsigned c = xb_ld(&bar[XB_XCNT(j)]); sum += c; cnt += (c > 0u) ? 1u : 0u; mine = (j == x) ? c : mine; }
        if (sum == G) break;
        __builtin_amdgcn_s_sleep(1);
        if ((++sp & 255u) == 0u) { if (xb_ld(&bar[XB_TMO])) break; if (sp > XB_SPIN_CAP) { atomicAdd(&bar[XB_TMO], 1u); break; } }
    }
    nloc = mine > 0u ? mine : 1u; nx = cnt > 0u ? cnt : 1u;
}
__device__ __forceinline__ void xcd_barrier(const XcdBarrier& b) {
    asm volatile("s_waitcnt vmcnt(0)" ::: "memory");
    __syncthreads();
    if (threadIdx.x == 0) {
        unsigned* bar = b.bar; const unsigned bx = (unsigned)__builtin_amdgcn_readfirstlane((int)xb_xcc_id());
        __builtin_amdgcn_s_waitcnt(0);
        unsigned nloc = b.st[0], nx = b.st[1];
        if (nloc == 0u) { xcd_barrier_complete(bar, bx, nloc, nx); b.st[0] = nloc; b.st[1] = nx; }
        const unsigned old = xb_add(&bar[XB_XSUB(bx)], 1u);
        const unsigned gen = old / nloc;
        if (old + 1u == (gen + 1u) * nloc) {
            __builtin_amdgcn_fence(__ATOMIC_RELEASE, "agent");
            asm volatile("s_waitcnt vmcnt(0)" ::: "memory");
            const unsigned og = xb_add(&bar[XB_TOP], 1u);
            const unsigned tg = og / nx;
            if (og + 1u == (tg + 1u) * nx) xb_add(&bar[XB_TOPGEN], 1u);
            else XB_SPIN(xb_ld(&bar[XB_TOPGEN]) == tg, bar);
            __builtin_amdgcn_fence(__ATOMIC_ACQUIRE, "agent");
            xb_add(&bar[XB_XGEN(bx)], 1u);
            asm volatile("s_waitcnt vmcnt(0)" ::: "memory");
        } else {
            XB_SPIN(xb_ld(&bar[XB_XGEN(bx)]) == gen, bar);
            __builtin_amdgcn_fence(__ATOMIC_ACQUIRE, "agent");
            asm volatile("s_waitcnt vmcnt(0)" ::: "memory");
        }
    }
    __syncthreads();
}

#ifndef WGM_IN
#define WGM_IN 8
#define WGM_OUT 4
#define WGM_FF1 8
#define WGM_FF2 4
#endif
__global__ void __launch_bounds__(NTHREADS, 2) mk_fwd(Params p) {
    extern __shared__ __attribute__((aligned(16))) unsigned char lds_raw[];
    LAS unsigned char* lds = (LAS unsigned char*)lds_raw;
    cg::grid_group grid = cg::this_grid();
    unsigned char* ws = p.ws; const int G = gridDim.x, bid = blockIdx.x;
    bf16_t* ACT = (bf16_t*)(ws + WS_ACT); bf16_t* PH = (bf16_t*)(ws + WS_PH); float* XC = (float*)(ws + WS_XC);

    volatile LAS unsigned* bst = (volatile LAS unsigned*)(lds + LDS_BYTES - 32);
    if (threadIdx.x == 0) { bst[0] = 0u; bst[1] = 0u; }
    __syncthreads();
    const XcdBarrier xb = xcd_barrier_post((unsigned*)(ws + WS_BAR), bst);
    grid.sync();
    phase_prologue(p, lds);
    xcd_barrier(xb);
#pragma nounroll
    for (int l = 0; l < 2; ++l) {
        const float* mod = (const float*)(ws + WS_MOD) + (size_t)l * 9 * 12288;
        const bf16_t* wt = (const bf16_t*)(ws + WS_WT + (size_t)l * WT_LAYER);
        const float* xin = l == 0 ? p.in[I_X] : p.out; const float* cin = l == 0 ? p.in[I_CTX] : XC;
        if (l == 0) filter_items(p, lds, G - 1 - bid, G);
        phase_norm_mod(xin, cin, p.in[I_N1G] + l * D, mod, 0, MT_ROWS, ACT);
        xcd_barrier(xb);
        { pg8::StaticOrder S; S.init(MT_ROWS, NINP, G, bid, WGM_IN); EpiBf16<0> E{PH, NINP, (float*)(ws + WS_GATE)};
          pg8::gemm_phase(lds, pg8::Gemm{ACT, wt + WT_IN_OFF / 2, MT_ROWS, NINP, D}, S, E); }
        xcd_barrier(xb);
        phase_qk(p, l);
        xcd_barrier(xb);
        phase_mixers(p, l, lds);
        xcd_barrier(xb);
        phase_combine(p, l, l == 0 ? MT_ROWS : ML_ROWS);
        xcd_barrier(xb);
        const int Mr = l == 0 ? MT_ROWS : ML_ROWS;
        { pg8::StaticOrder S; S.init(Mr, D, G, bid, WGM_OUT); EpiRes E{xin, p.out, cin, XC, mod, 2};
          pg8::gemm_phase(lds, pg8::Gemm{ACT, wt + WT_OUT_OFF / 2, Mr, D, D}, S, E); }
        xcd_barrier(xb);
        phase_norm_mod(p.out, XC, p.in[I_N2G] + l * D, mod, 3, Mr, ACT);
        xcd_barrier(xb);
        { pg8::StaticOrder S; S.init(Mr, DFF, G, bid, WGM_FF1); EpiBf16<1> E{PH, DFF, nullptr};
          pg8::gemm_phase(lds, pg8::Gemm{ACT, wt + WT_FF1_OFF / 2, Mr, DFF, D}, S, E); }
        xcd_barrier(xb);
        { pg8::StaticOrder S; S.init(Mr, D, G, bid, WGM_FF2); EpiRes E{p.out, p.out, XC, XC, mod, 5};
          pg8::gemm_phase(lds, pg8::Gemm{PH, wt + WT_FF2_OFF / 2, Mr, D, DFF}, S, E); }
        xcd_barrier(xb);
    }
    phase_final(p);
}

extern "C" void kernel_launch(void* const* d_in, const int* in_sizes, int n_in, void* d_out, int out_size, void* d_ws, size_t ws_size, hipStream_t stream) {
    static int grid = 0;
    if (!grid) {
        int dev = 0, cus = 0, per_cu = 0;
        (void)hipGetDevice(&dev);
        (void)hipDeviceGetAttribute(&cus, hipDeviceAttributeMultiprocessorCount, dev);
        (void)hipFuncSetAttribute((const void*)mk_fwd, hipFuncAttributeMaxDynamicSharedMemorySize, LDS_BYTES);
        (void)hipOccupancyMaxActiveBlocksPerMultiprocessor(&per_cu, (const void*)mk_fwd, NTHREADS, LDS_BYTES);
        if (per_cu < 1) per_cu = 1;
        grid = cus * per_cu;
        if (ws_size < WS_END || n_in != 25) { fprintf(stderr, "kernel_launch: workspace %zu < %zu or n_in %d != 25\n", ws_size, (size_t)WS_END, n_in); }
    }
    (void)hipMemsetAsync((unsigned char*)d_ws + WS_BAR, 0, 16384, stream);
    Params p{};
    for (int i = 0; i < 25; ++i) p.in[i] = (const float*)d_in[i];
    p.out = (float*)d_out; p.ws = (unsigned char*)d_ws;
    void* args[] = {&p};
    hipError_t e = hipLaunchCooperativeKernel((const void*)mk_fwd, dim3(grid), dim3(NTHREADS), args, LDS_BYTES, stream);
    if (e != hipSuccess) fprintf(stderr, "cooperative launch failed: %s (grid %d)\n", hipGetErrorString(e), grid);
}
```
